# Optimizing an MI355X kernel written in HIP

```python
import jax, jax.numpy as jnp
from jax import lax
import numpy as np

D_MODEL = 1024
BATCH = 32
SEQ = 256
DEPTH = 1
DEC_BATCH = 8
DEC_SEQ = 1024
PAST_LEN = 256

GRID_W = 64
N_HEADS = 8
N_KV_HEADS = 2
GROUP = N_HEADS // N_KV_HEADS
HEAD_DIM = 64
WINDOW = 128
BLOCK = 128
F_GROUPS = 4
F_GROUP_DIM = 128
F_WIDTH = F_GROUPS * F_GROUP_DIM
ATTN_WIDTH = N_HEADS * HEAD_DIM
KV_WIDTH = N_KV_HEADS * HEAD_DIM
N_BRANCHES = 2
IN_WIDTH = F_WIDTH + ATTN_WIDTH + 2 * KV_WIDTH + N_BRANCHES * D_MODEL
D_FF = ((8 * D_MODEL + 3 * 256 - 1) // (3 * 256)) * 256
ROPE_THETA = 10000.0
EPS = 1e-6
NEG_INF = -1e30

kernel_name = "hybrid_fnet_swa_diffusion_step"


def rms_norm(x, g):
    xf = x.astype(jnp.float32)
    y = xf * lax.rsqrt(jnp.mean(xf * xf, axis=-1, keepdims=True) + EPS)
    return (y * g.astype(jnp.float32)).astype(x.dtype)


def adaln(cvec, w_ada, b_ada):
    mod = jax.nn.silu(cvec) @ w_ada + b_ada
    return jnp.split(mod, 6, axis=-1)


def mixer_project(h, w_in, g_q, g_k):
    b, n, _ = h.shape
    z = h @ w_in
    zf, zq, zk, zv, zg = jnp.split(
        z, [F_WIDTH, F_WIDTH + ATTN_WIDTH, F_WIDTH + ATTN_WIDTH + KV_WIDTH,
            F_WIDTH + ATTN_WIDTH + 2 * KV_WIDTH], axis=-1)
    q = rms_norm(zq.reshape(b, n, N_HEADS, HEAD_DIM), g_q)
    k = rms_norm(zk.reshape(b, n, N_KV_HEADS, HEAD_DIM), g_k)
    v = zv.reshape(b, n, N_KV_HEADS, HEAD_DIM)
    return zf, q, k, v, zg


def fourier_mix(zf, w_f):
    b, n, _ = zf.shape
    zgrp = zf.reshape(b, n, F_GROUPS, F_GROUP_DIM).astype(jnp.float32)
    mixed = jnp.real(jnp.fft.fft2(zgrp, axes=(1, 3), norm="ortho"))
    return mixed.reshape(b, n, F_WIDTH).astype(zf.dtype) @ w_f


def axial_rope(x):
    n = x.shape[1]
    rows = n // GRID_W
    row = jnp.repeat(jnp.arange(rows, dtype=jnp.float32), GRID_W)
    col = jnp.tile(jnp.arange(GRID_W, dtype=jnp.float32), rows)
    axis_dim = HEAD_DIM // 2
    inv_freq = ROPE_THETA ** (-jnp.arange(0, axis_dim, 2, dtype=jnp.float32) / axis_dim)
    xf = x.astype(jnp.float32)

    def rotate(xa, pos):
        ang = pos[:, None] * inv_freq[None, :]
        cos = jnp.cos(ang)[None, :, None, :]
        sin = jnp.sin(ang)[None, :, None, :]
        x1, x2 = jnp.split(xa, 2, axis=-1)
        return jnp.concatenate([x1 * cos - x2 * sin, x1 * sin + x2 * cos], axis=-1)

    out = jnp.concatenate([rotate(xf[..., :axis_dim], row), rotate(xf[..., axis_dim:], col)], axis=-1)
    return out.astype(x.dtype)


def sink_softmax(sc, sink):
    s = sink[:, :, None]
    m = jnp.maximum(jnp.max(sc, axis=-1), s)
    p = jnp.exp(sc - m[..., None])
    return p / (jnp.sum(p, axis=-1) + jnp.exp(s - m))[..., None]


def context_attention(q, k, v, sink):
    b, s = q.shape[:2]
    scale = HEAD_DIM ** -0.5
    qb = jnp.moveaxis(q.reshape(b, s // BLOCK, BLOCK, N_KV_HEADS, GROUP, HEAD_DIM), 1, 0)

    def one_block(qblk):
        sc = jnp.einsum("bqkgd,bjkd->bkgqj", qblk, k).astype(jnp.float32) * scale
        p = sink_softmax(sc, sink).astype(v.dtype)
        return jnp.einsum("bkgqj,bjkd->bqkgd", p, v)

    out = lax.map(one_block, qb)
    return jnp.moveaxis(out, 0, 1).reshape(b, s, ATTN_WIDTH)


def latent_attention(q, k, v, ck, cv, sink):
    b, n = q.shape[:2]
    nb = n // BLOCK
    scale = HEAD_DIM ** -0.5
    qb = q.reshape(b, nb, BLOCK, N_KV_HEADS, GROUP, HEAD_DIM)
    pad = ((0, 0), (BLOCK, BLOCK), (0, 0), (0, 0))
    kb = jnp.pad(k, pad).reshape(b, nb + 2, BLOCK, N_KV_HEADS, HEAD_DIM)
    vb = jnp.pad(v, pad).reshape(b, nb + 2, BLOCK, N_KV_HEADS, HEAD_DIM)
    kwin = jnp.concatenate([kb[:, :-2], kb[:, 1:-1], kb[:, 2:]], axis=2)
    vwin = jnp.concatenate([vb[:, :-2], vb[:, 1:-1], vb[:, 2:]], axis=2)
    q_pos = jnp.arange(n).reshape(nb, BLOCK)
    k_pos = (jnp.arange(nb)[:, None] - 1) * BLOCK + jnp.arange(3 * BLOCK)[None, :]
    mask = ((jnp.abs(q_pos[:, :, None] - k_pos[:, None, :]) <= WINDOW)
            & (k_pos[:, None, :] >= 0) & (k_pos[:, None, :] < n))
    s_loc = jnp.einsum("bnqkgd,bnjkd->bnkgqj", qb, kwin).astype(jnp.float32) * scale
    s_loc = jnp.where(mask[None, :, None, None, :, :], s_loc, NEG_INF)
    s_ctx = jnp.einsum("bnqkgd,bjkd->bnkgqj", qb, ck).astype(jnp.float32) * scale
    p = sink_softmax(jnp.concatenate([s_loc, s_ctx], axis=-1), sink).astype(v.dtype)
    out = (jnp.einsum("bnkgqj,bnjkd->bnqkgd", p[..., :3 * BLOCK], vwin)
           + jnp.einsum("bnkgqj,bjkd->bnqkgd", p[..., 3 * BLOCK:], cv))
    return out.reshape(b, n, ATTN_WIDTH)


def merge_branches(yf, ya, zg, w_out):
    gf, ga = jnp.split(jax.nn.sigmoid(zg), N_BRANCHES, axis=-1)
    return (gf * yf + ga * ya) @ w_out


def swiglu(h, w_up, w_down):
    a, u = jnp.split(h @ w_up, 2, axis=-1)
    return (jax.nn.silu(a) * u) @ w_down


def trunk_layer(x, cvec, attend, w_ada, b_ada, g_norm1, g_norm2, w_in, g_q, g_k,
                w_f, w_ao, w_out, w_up, w_down):
    sh1, sc1, gt1, sh2, sc2, gt2 = adaln(cvec, w_ada, b_ada)
    h = rms_norm(x, g_norm1) * (1.0 + sc1) + sh1
    zf, q, k, v, zg = mixer_project(h, w_in, g_q, g_k)
    yf = fourier_mix(zf, w_f)
    ya = attend(q, k, v) @ w_ao
    x = x + gt1 * merge_branches(yf, ya, zg, w_out)
    h = rms_norm(x, g_norm2) * (1.0 + sc2) + sh2
    x = x + gt2 * swiglu(h, w_up, w_down)
    return x, k, v


def setup_inputs(seed: int = 0) -> dict:
    key = jax.random.key(seed)
    ks = jax.random.split(key, 20)

    def nrm(k, shape, s):
        return jax.random.normal(k, shape, jnp.float32) * s

    cache_shape = (DEC_BATCH, DEPTH, PAST_LEN, N_KV_HEADS, HEAD_DIM)
    return {
        "x_prompt": nrm(ks[0], (BATCH, SEQ, D_MODEL), 1.0),
        "x_sample": nrm(ks[1], (DEC_BATCH, DEC_SEQ, D_MODEL), 1.0),
        "cache_k": nrm(ks[2], cache_shape, 1.0),
        "cache_v": nrm(ks[3], cache_shape, 1.0),
        "c": nrm(ks[4], (DEC_BATCH, D_MODEL), 1.0),
        "c_ctx": nrm(ks[5], (D_MODEL,), 1.0),
        "w_ada": nrm(ks[6], (DEPTH, D_MODEL, 6 * D_MODEL), 0.5 * D_MODEL ** -0.5),
        "b_ada": nrm(ks[7], (DEPTH, 6 * D_MODEL), 0.01),
        "g_norm1": 1.0 + nrm(ks[8], (DEPTH, D_MODEL), 0.02),
        "g_norm2": 1.0 + nrm(ks[9], (DEPTH, D_MODEL), 0.02),
        "w_in": nrm(ks[10], (DEPTH, D_MODEL, IN_WIDTH), D_MODEL ** -0.5),
        "g_q": 1.0 + nrm(ks[11], (DEPTH, HEAD_DIM), 0.02),
        "g_k": 1.0 + nrm(ks[12], (DEPTH, HEAD_DIM), 0.02),
        "sinks": nrm(ks[13], (DEPTH, N_HEADS), 1.0),
        "w_f": nrm(ks[14], (DEPTH, F_WIDTH, D_MODEL), F_WIDTH ** -0.5),
        "w_ao": nrm(ks[15], (DEPTH, ATTN_WIDTH, D_MODEL), ATTN_WIDTH ** -0.5),
        "w_out": nrm(ks[16], (DEPTH, D_MODEL, D_MODEL), D_MODEL ** -0.5),
        "w_up": nrm(ks[17], (DEPTH, D_MODEL, 2 * D_FF), D_MODEL ** -0.5),
        "w_down": nrm(ks[18], (DEPTH, D_FF, D_MODEL), D_FF ** -0.5),
    }


def reference(x_prompt, x_sample, cache_k, cache_v, c, c_ctx, w_ada, b_ada, g_norm1, g_norm2,
              w_in, g_q, g_k, sinks, w_f, w_ao, w_out, w_up, w_down):
    xp = x_prompt
    xs = x_sample
    new_k = []
    new_v = []
    for l in range(DEPTH):
        sink = sinks[l].reshape(N_KV_HEADS, GROUP).astype(jnp.float32)
        params = (w_ada[l], b_ada[l], g_norm1[l], g_norm2[l], w_in[l], g_q[l], g_k[l],
                  w_f[l], w_ao[l], w_out[l], w_up[l], w_down[l])

        def attend_ctx(q, k, v, sink=sink):
            return context_attention(q, k, v, sink)

        xp, k_ctx, v_ctx = trunk_layer(xp, c_ctx[None, None, :], attend_ctx, *params)
        new_k.append(k_ctx)
        new_v.append(v_ctx)

        ck = cache_k[:, l]
        cv = cache_v[:, l]

        def attend_lat(q, k, v, sink=sink, ck=ck, cv=cv):
            return latent_attention(axial_rope(q), axial_rope(k), v, ck, cv, sink)

        xs, _, _ = trunk_layer(xs, c[:, None, :], attend_lat, *params)

    new_cache_k = jnp.stack(new_k, axis=1)
    new_cache_v = jnp.stack(new_v, axis=1)
    return (xp, xs, new_cache_k, new_cache_v)
```

```cpp
#include <hip/hip_runtime.h>
#include <hip/hip_cooperative_groups.h>
#include <cstdio>
#include <cstdint>
namespace cg = cooperative_groups;

#ifndef MK_N_LAUNCHES
#define MK_N_LAUNCHES 1
#endif

#define LAS __attribute__((address_space(3)))
typedef unsigned short bf16_t;
typedef short bf16x8 __attribute__((ext_vector_type(8)));
typedef float f32x4 __attribute__((ext_vector_type(4)));
typedef unsigned u32x4 __attribute__((ext_vector_type(4)));
typedef unsigned u32x2 __attribute__((ext_vector_type(2)));

typedef float f32x2_t __attribute__((ext_vector_type(2))); typedef __bf16 bf16x2_t __attribute__((ext_vector_type(2)));
__device__ __forceinline__ unsigned cvt_pk_bf16(float lo, float hi) { f32x2_t v = {lo, hi}; bf16x2_t b = __builtin_convertvector(v, bf16x2_t); return __builtin_bit_cast(unsigned, b); }
__device__ __forceinline__ float bf_lo(unsigned w) { return __uint_as_float(w << 16); }
__device__ __forceinline__ float bf_hi(unsigned w) { return __uint_as_float(w & 0xffff0000u); }
__device__ __forceinline__ unsigned f2bf(float f) { unsigned u = __float_as_uint(f); return (u + 0x7fffu + ((u >> 16) & 1u)) >> 16; }

constexpr int DM = 1024, MTOK = 16384, NPROMPT = 8192;
constexpr int INW = 3328, DFF = 2816;
constexpr size_t MiB = 1u << 20;
constexpr size_t WS_MODP = 1 * MiB;
constexpr size_t WS_MOD = 3 * MiB;
constexpr size_t WS_ROPE = 3 * MiB + 512 * 1024;
constexpr size_t WS_WIN = 4 * MiB;
constexpr size_t WS_WCAT = 11 * MiB;
constexpr size_t WS_WOUT = 14 * MiB;
constexpr size_t WS_WUP = 16 * MiB;
constexpr size_t WS_WDN = 27 * MiB;
constexpr size_t WS_DFT = 33 * MiB;
constexpr size_t WS_CK = 38 * MiB, WS_CV = 38 * MiB + 512 * 1024;
constexpr size_t WS_H = 40 * MiB;
constexpr size_t WS_ZFT = 72 * MiB;
constexpr size_t WS_Q = 88 * MiB;
constexpr size_t WS_K = 104 * MiB, WS_V = 108 * MiB;
constexpr size_t WS_G = 112 * MiB;
constexpr size_t WS_ABX = 176 * MiB;
constexpr size_t WS_T = 224 * MiB;
constexpr size_t WS_ACT = 72 * MiB;
constexpr int LDS_BYTES = 147456;

__device__ __forceinline__ unsigned xb_ld(unsigned* p)              { return __hip_atomic_load(p, __ATOMIC_RELAXED, __HIP_MEMORY_SCOPE_AGENT); }
__device__ __forceinline__ unsigned xb_add(unsigned* p, unsigned v) { return __hip_atomic_fetch_add(p, v, __ATOMIC_RELAXED, __HIP_MEMORY_SCOPE_AGENT); }
namespace pg8 {
constexpr int BM = 256, BK = 64, HALF = 128, HTB = HALF * BK * 2, STAGE_BYTES = 8 * HTB, NXCD = 8, WGM = 8;
__host__ __device__ __forceinline__ int lds_byte(int r, int c) { const int st = (r >> 4) * 2 + (c >> 5), rr = r & 15, cc = c & 31, ob = rr * 64 + cc * 2; return st * 1024 + (ob ^ (((ob >> 9) & 1) << 5)); }
__host__ __device__ __forceinline__ void stage_rc(int b, int& R, int& C) { const int st = b / 1024, sb = b % 1024, swz = sb ^ (((sb >> 9) & 1) << 5); R = (st >> 1) * 16 + swz / 64; C = (st & 1) * 32 + (swz % 64) / 2; }
__host__ __device__ __forceinline__ int perm32(int rho) { const int n = rho >> 4, i = rho & 15; return 8 * (i >> 2) + 4 * n + (i & 3); }

struct Unit { const char* A; const char* B; int nt, pm, pn, tag; };

__device__ __forceinline__ void tile_of(int L, int nM, int nN, int& pm, int& pn) {
    const int nwg = nM * nN; int wgid = L;
    { const int q = nwg / NXCD, r = nwg % NXCD, xcd = wgid % NXCD, off = wgid / NXCD; wgid = (xcd < r ? xcd * (q + 1) : r * (q + 1) + (xcd - r) * q) + off; }
    const int nig = WGM * nN, gid = wgid / nig, fm = gid * WGM, gsz = (nM - fm) < WGM ? (nM - fm) : WGM;
    pm = fm + ((wgid % nig) % gsz); pn = (wgid % nig) / gsz;
}

template <class Epi, class Sched>
__device__ __forceinline__ void gemm_phase(LAS unsigned char* lds, const int lda, const int ldb, const Sched& S, const Epi& E) {
    const int tid = threadIdx.x, wid = __builtin_amdgcn_readfirstlane(tid >> 6), lane = tid & 63, wr = wid >> 2, wc = wid & 3, fr = lane & 15, fq = lane >> 4;
    unsigned voffA[2], voffB[2];
#pragma unroll
    for (int i = 0; i < 2; ++i) { int R, C; stage_rc(tid * 16 + i * 8192, R, C); const int Rb = Epi::PERM ? ((R & ~31) + perm32(R & 31)) : R;
        voffA[i] = (unsigned)(R * lda + C) * 2u; voffB[i] = (unsigned)(Rb * ldb + C) * 2u; }
    const size_t kstep = (size_t)(BK * 2);
    const size_t hstepA = (size_t)HALF * lda * 2, hstepB = (size_t)HALF * ldb * 2;
    const unsigned ldsw = (unsigned)wid * 1024u;
    const int aoff = lds_byte(wr * 64 + fr, fq * 8), boff = lds_byte(wc * 32 + fr, fq * 8);
#define PG8_SA(b, h) (((b) * 2 + (h)) * HTB)
#define PG8_SB(b, h) ((4 + (b) * 2 + (h)) * HTB)
#define PG8_STAGE(bufoff, gbase, voff) do { _Pragma("unroll") for (int _i = 0; _i < 2; ++_i) \
        __builtin_amdgcn_global_load_lds((const unsigned*)((const char*)(gbase) + (voff)[_i]), (LAS unsigned*)(lds + (bufoff) + ldsw + _i * 8192), 16, 0, 0); } while (0)
#define PG8_LDA(dst, b, h) do { _Pragma("unroll") for (int m = 0; m < 4; ++m) _Pragma("unroll") for (int k = 0; k < 2; ++k) dst[m][k] = *(const LAS bf16x8*)(lds + PG8_SA(b, h) + aoff + m * 2048 + k * 1024); } while (0)
#define PG8_LDB(dst, b, h) do { _Pragma("unroll") for (int n = 0; n < 2; ++n) _Pragma("unroll") for (int k = 0; k < 2; ++k) dst[n][k] = *(const LAS bf16x8*)(lds + PG8_SB(b, h) + boff + n * 2048 + k * 1024); } while (0)
#define PG8_MMA(ai, bj, At, Bt) do { __builtin_amdgcn_s_setprio(1); _Pragma("unroll") for (int m = 0; m < 4; ++m) _Pragma("unroll") for (int n = 0; n < 2; ++n) _Pragma("unroll") for (int k = 0; k < 2; ++k) \
        acc[ai][bj][m][n] = __builtin_amdgcn_mfma_f32_16x16x32_bf16(Bt[n][k], At[m][k], acc[ai][bj][m][n], 0, 0, 0); __builtin_amdgcn_s_setprio(0); } while (0)
#define PG8_WAIT_V(n) asm volatile("s_waitcnt vmcnt(" #n ")" ::: "memory")
#define PG8_WAIT_L(n) asm volatile("s_waitcnt lgkmcnt(" #n ")" ::: "memory")
#define PG8_BAR __builtin_amdgcn_s_barrier()
#define PG8_SCHED __builtin_amdgcn_sched_barrier(0)
    Unit cur, nxt; int ui = 0;
    if (!S.next(0, cur)) return;
    f32x4 acc[2][2][4][2];
#pragma unroll
    for (int a = 0; a < 2; ++a)
#pragma unroll
        for (int b = 0; b < 2; ++b)
#pragma unroll
            for (int m = 0; m < 4; ++m)
#pragma unroll
                for (int n = 0; n < 2; ++n) acc[a][b][m][n] = (f32x4){0.f, 0.f, 0.f, 0.f};
    bf16x8 At[4][2], B0[2][2], B1[2][2];
    const char* cA = cur.A; const char* cB = cur.B;
    PG8_STAGE(PG8_SB(0, 0), cB, voffB); PG8_STAGE(PG8_SB(0, 1), cB + hstepB, voffB); PG8_STAGE(PG8_SA(0, 0), cA, voffA); PG8_STAGE(PG8_SA(0, 1), cA + hstepA, voffA);
    if (wr == 1) PG8_BAR;
    PG8_WAIT_V(2); PG8_BAR;
    PG8_STAGE(PG8_SB(1, 0), cB + kstep, voffB); PG8_STAGE(PG8_SA(1, 0), cA + kstep, voffA); PG8_STAGE(PG8_SB(1, 1), cB + hstepB + kstep, voffB);
    PG8_WAIT_V(6); PG8_BAR;
    for (;;) {
        const bool has_next = S.next(ui + 1, nxt);
        const char* nA = has_next ? nxt.A : cA; const char* nB = has_next ? nxt.B : cB;
        const int nt = cur.nt;
        for (int t = 0; t < nt; t += 2) {
            const bool last = (t == nt - 2);
            const char* a1 = cA + (size_t)(t + 1) * kstep;
            const char* a2 = last ? nA : cA + (size_t)(t + 2) * kstep; const char* b2 = last ? nB : cB + (size_t)(t + 2) * kstep;
            const char* a3 = a2 + kstep; const char* b3 = b2 + kstep;
            PG8_LDB(B0, 0, 0); PG8_LDB(B1, 0, 1); PG8_SCHED; PG8_LDA(At, 0, 0); PG8_STAGE(PG8_SA(1, 1), a1 + hstepA, voffA);
            PG8_WAIT_V(8); PG8_WAIT_L(0); PG8_BAR; PG8_MMA(0, 0, At, B0); PG8_MMA(0, 1, At, B1); PG8_BAR; PG8_SCHED;
            PG8_LDA(At, 0, 1); PG8_STAGE(PG8_SB(0, 0), b2, voffB); PG8_STAGE(PG8_SB(0, 1), b2 + hstepB, voffB); PG8_STAGE(PG8_SA(0, 0), a2, voffA);
            PG8_WAIT_V(8); PG8_WAIT_L(0); PG8_BAR; PG8_MMA(1, 0, At, B0); PG8_MMA(1, 1, At, B1); PG8_BAR; PG8_SCHED;
            PG8_LDB(B0, 1, 0); PG8_LDB(B1, 1, 1); PG8_SCHED; PG8_LDA(At, 1, 0); PG8_STAGE(PG8_SA(0, 1), a2 + hstepA, voffA);
            PG8_WAIT_V(8); PG8_WAIT_L(0); PG8_BAR; PG8_MMA(0, 0, At, B0); PG8_MMA(0, 1, At, B1); PG8_BAR; PG8_SCHED;
            PG8_LDA(At, 1, 1); PG8_STAGE(PG8_SB(1, 0), b3, voffB); PG8_STAGE(PG8_SB(1, 1), b3 + hstepB, voffB); PG8_STAGE(PG8_SA(1, 0), a3, voffA);
            PG8_WAIT_V(8); PG8_WAIT_L(0); PG8_BAR; PG8_MMA(1, 0, At, B0); PG8_MMA(1, 1, At, B1); PG8_BAR; PG8_SCHED;
        }
        if (wr == 0) PG8_BAR;
        if constexpr (!Epi::AFTER_DRAIN) E(acc, cur, wr, wc, fr, fq);
        if (!has_next) break;
#pragma unroll
        for (int a = 0; a < 2; ++a)
#pragma unroll
            for (int b = 0; b < 2; ++b)
#pragma unroll
                for (int m = 0; m < 4; ++m)
#pragma unroll
                    for (int n = 0; n < 2; ++n) acc[a][b][m][n] = (f32x4){0.f, 0.f, 0.f, 0.f};
        cur = nxt; cA = nA; cB = nB; ++ui;
        if (wr == 1) PG8_BAR;
    }
    PG8_WAIT_V(0);
    PG8_BAR;
    if constexpr (Epi::AFTER_DRAIN) E.fused(acc, cur, wr, wc, fr, fq, lds, tid, lane);
#undef PG8_SA
#undef PG8_SB
#undef PG8_STAGE
#undef PG8_LDA
#undef PG8_LDB
#undef PG8_MMA
#undef PG8_WAIT_V
#undef PG8_WAIT_L
#undef PG8_BAR
#undef PG8_SCHED
}

struct SchedGrid {
    int G, c, nM, nN, nt; const char* A; const char* B; size_t tsA, tsB; int rep;
    __device__ __forceinline__ bool next(int i, Unit& u) const {
        long L = (long)i * G + c; if (L >= (long)nM * nN * rep) return false; L %= (long)nM * nN;
        int pm, pn; tile_of((int)L, nM, nN, pm, pn);
        u.pm = pm; u.pn = pn; u.tag = 0; u.nt = nt; u.A = A + (size_t)pm * tsA; u.B = B + (size_t)pn * tsB; return true;
    }
};
struct SchedP2 {
    int G, c; const char* H; const char* W; int rep;
    __device__ __forceinline__ bool next(int i, Unit& u) const {
        long L = (long)i * G + c; if (L >= 64 * 13 * rep) return false; L %= 64 * 13;
        int pm, pn; tile_of((int)L, 64, 13, pm, pn);
        const size_t ts = (size_t)256 * 1024 * 2;
        u.pm = pm; u.pn = pn; u.tag = pn; u.nt = 16;
        if (pn < 11) { u.A = H + (size_t)pm * ts; u.B = W + 2 * ts + (size_t)pn * ts; }
        else { u.A = W + (size_t)(pn - 11) * ts; u.B = H + (size_t)pm * ts; }
        return true;
    }
};
struct SchedDft {
    int G, c; const char* D; const char* Z; int rep;
    __device__ __forceinline__ bool next(int i, Unit& u) const {
        const long Ll = (long)i * G + c; if (Ll >= 256 * rep) return false; const int L = (int)(Ll % 256);
        u.tag = 0;
        if (L < 128) { const int b = L >> 4, rem = L & 15, pmq = rem >> 2, cs = (rem >> 1) & 1, pnq = rem & 1;
            u.A = D + (size_t)cs * (1024 * 1024 * 2) + (size_t)pmq * (256 * 1024 * 2);
            u.B = Z + ((size_t)pnq * 256 * 16384 + 8192 + b * 1024) * 2; u.nt = 16; u.pm = 32 + b * 4 + pmq; u.pn = cs * 2 + pnq; }
        else { const int L2 = L - 128, b = L2 >> 2, cs = (L2 >> 1) & 1, pnq = L2 & 1;
            u.A = D + (size_t)2 * (1024 * 1024 * 2) + (size_t)cs * (256 * 1024 * 2);
            u.B = Z + ((size_t)pnq * 256 * 16384 + b * 256) * 2; u.nt = 4; u.pm = b; u.pn = cs * 2 + pnq; }
        return true;
    }
};
struct SchedP4 {
    int G, c; const char* X; const char* W; int rep;
    __device__ __forceinline__ bool next(int i, Unit& u) const {
        long Lt = (long)(i >> 1) * G + c; if (Lt >= 256 * rep) return false; Lt %= 256;
        int pm, pn; tile_of((int)Lt, 64, 4, pm, pn); const int sub = i & 1;
        u.pm = pm; u.pn = pn; u.tag = sub; u.nt = sub ? 8 : 16;
        u.A = X + (size_t)pm * 256 * 1536 * 2 + (sub ? 2048 : 0); u.B = W + (size_t)pn * 256 * 1536 * 2 + (sub ? 2048 : 0); return true;
    }
};

struct EpiP2 {
    static constexpr bool AFTER_DRAIN = false;
    static constexpr bool PERM = false;
    bf16_t *Q, *Kb, *Vb, *Gt, *ZT; float *ock, *ocv; const float *gq, *gk, *ropeC, *ropeS;
    __device__ __forceinline__ void operator()(const f32x4 (&acc)[2][2][4][2], const Unit& u, int wr, int wc, int fr, int fq) const {
        const int pn = u.pn;
        if (pn >= 11) {
            const int ch0 = (pn - 11) * 256 + wr * 64 + fr, tok0 = u.pm * 256 + wc * 32 + 4 * fq;
#pragma unroll
            for (int ai = 0; ai < 2; ++ai)
#pragma unroll
                for (int m = 0; m < 4; ++m) { bf16_t* rowp = ZT + (size_t)(ch0 + ai * 128 + m * 16) * 16384 + tok0;
#pragma unroll
                    for (int bj = 0; bj < 2; ++bj)
#pragma unroll
                        for (int n = 0; n < 2; ++n) { const f32x4 v = acc[ai][bj][m][n]; u32x2 w; w.x = cvt_pk_bf16(v[0], v[1]); w.y = cvt_pk_bf16(v[2], v[3]); *(u32x2*)(rowp + bj * 128 + n * 16) = w; } }
        } else if (pn >= 3) {
            const int row0 = u.pm * 256 + wr * 64 + fr, col0 = (pn - 3) * 256 + wc * 32 + 4 * fq;
#pragma unroll
            for (int ai = 0; ai < 2; ++ai)
#pragma unroll
                for (int m = 0; m < 4; ++m) { bf16_t* rowp = Gt + (size_t)(row0 + ai * 128 + m * 16) * 2048 + col0;
#pragma unroll
                    for (int bj = 0; bj < 2; ++bj)
#pragma unroll
                        for (int n = 0; n < 2; ++n) { const f32x4 v = acc[ai][bj][m][n]; float s[4];
#pragma unroll
                            for (int j = 0; j < 4; ++j) s[j] = __builtin_amdgcn_rcpf(1.f + __expf(-v[j]));
                            u32x2 w; w.x = cvt_pk_bf16(s[0], s[1]); w.y = cvt_pk_bf16(s[2], s[3]); *(u32x2*)(rowp + bj * 128 + n * 16) = w; } }
        } else {
            const bool lat = u.pm >= 32, isv = (pn == 2 && wc >= 2);
            f32x4 g[2][2];
#pragma unroll
            for (int bj = 0; bj < 2; ++bj)
#pragma unroll
                for (int n = 0; n < 2; ++n) { const f32x4 ga = *(const f32x4*)(gq + 32 * bj + 16 * n + 4 * fq), gb = *(const f32x4*)(gk + 32 * bj + 16 * n + 4 * fq); g[bj][n] = pn < 2 ? ga : gb; }
#pragma unroll
            for (int ai = 0; ai < 2; ++ai)
#pragma unroll
                for (int m = 0; m < 4; ++m) {
                    const int r = u.pm * 256 + ai * 128 + wr * 64 + m * 16 + fr;
                    f32x4 v[2][2];
#pragma unroll
                    for (int bj = 0; bj < 2; ++bj)
#pragma unroll
                        for (int n = 0; n < 2; ++n) v[bj][n] = acc[ai][bj][m][n];
                    if (!isv) {
                        float ss = 0.f;
#pragma unroll
                        for (int bj = 0; bj < 2; ++bj)
#pragma unroll
                            for (int n = 0; n < 2; ++n) { const f32x4 x = v[bj][n]; ss += (x[0] * x[0] + x[1] * x[1]) + (x[2] * x[2] + x[3] * x[3]); }
                        ss += __shfl_xor(ss, 16); ss += __shfl_xor(ss, 32);
                        const float rstd = rsqrtf(ss * (1.f / 64.f) + 1e-6f);
#pragma unroll
                        for (int bj = 0; bj < 2; ++bj)
#pragma unroll
                            for (int n = 0; n < 2; ++n) v[bj][n] = v[bj][n] * rstd * g[bj][n];
                    }
                    if (pn == 2 && !lat) {
                        float* o = ock + (isv ? (size_t)NPROMPT * 128 : (size_t)0) + (size_t)r * 128 + (wc & 1) * 64 + 4 * fq;
#pragma unroll
                        for (int bj = 0; bj < 2; ++bj)
#pragma unroll
                            for (int n = 0; n < 2; ++n) *(f32x4*)(o + 32 * bj + 16 * n) = v[bj][n];
                    }
                    if (!isv && lat) {
                        const int s = (r - NPROMPT) & 1023;
#pragma unroll
                        for (int bj = 0; bj < 2; ++bj) { const int pos = bj ? (s & 63) : (s >> 6);
                            const f32x4 ct = *(const f32x4*)(ropeC + pos * 16 + 4 * fq), sn = *(const f32x4*)(ropeS + pos * 16 + 4 * fq);
                            const f32x4 x1 = v[bj][0], x2 = v[bj][1]; v[bj][0] = x1 * ct - x2 * sn; v[bj][1] = x1 * sn + x2 * ct; }
                    }
                    const size_t doff = (pn < 2) ? (size_t)r * 512 + (4 * pn + wc) * 64 : (isv ? (WS_V - WS_Q) / 2 : (WS_K - WS_Q) / 2) + (size_t)r * 128 + (wc & 1) * 64;
                    bf16_t* dst = Q + doff;
#pragma unroll
                    for (int bj = 0; bj < 2; ++bj)
#pragma unroll
                        for (int n = 0; n < 2; ++n) { const f32x4 x = v[bj][n]; u32x2 w; w.x = cvt_pk_bf16(x[0], x[1]); w.y = cvt_pk_bf16(x[2], x[3]); *(u32x2*)(dst + 32 * bj + 16 * n + 4 * fq) = w; }
                }
        }
    }
};
struct EpiStore {
    static constexpr bool AFTER_DRAIN = false;
    static constexpr bool PERM = true;
    bf16_t* O; int ldc;
    __device__ __forceinline__ void operator()(const f32x4 (&acc)[2][2][4][2], const Unit& u, int wr, int wc, int fr, int fq) const {
        const int row0 = u.pm * 256 + wr * 64 + fr, col0 = u.pn * 256 + wc * 32 + 8 * fq;
#pragma unroll
        for (int ai = 0; ai < 2; ++ai)
#pragma unroll
            for (int m = 0; m < 4; ++m) { bf16_t* rowp = O + (size_t)(row0 + ai * 128 + m * 16) * ldc + col0;
#pragma unroll
                for (int bj = 0; bj < 2; ++bj) { const f32x4 v0 = acc[ai][bj][m][0], v1 = acc[ai][bj][m][1];
                    u32x4 w; w.x = cvt_pk_bf16(v0[0], v0[1]); w.y = cvt_pk_bf16(v0[2], v0[3]); w.z = cvt_pk_bf16(v1[0], v1[1]); w.w = cvt_pk_bf16(v1[2], v1[3]);
                    *(u32x4*)(rowp + bj * 128) = w; } }
    }
};
struct EpiP4 {
    static constexpr bool AFTER_DRAIN = false;
    static constexpr bool PERM = true;
    bf16_t* T; const bf16_t* Gt;
    static constexpr long MRG_OFF = ((long)WS_H - (long)WS_T) / 2;
    __device__ __forceinline__ void operator()(const f32x4 (&acc)[2][2][4][2], const Unit& u, int wr, int wc, int fr, int fq) const {
        const int row0 = u.pm * 256 + wr * 64 + fr, col0 = u.pn * 256 + wc * 32 + 8 * fq; const int sub = u.tag;
#pragma unroll
        for (int ai = 0; ai < 2; ++ai)
#pragma unroll
            for (int m = 0; m < 4; ++m) { const size_t r = (size_t)(row0 + ai * 128 + m * 16);
#pragma unroll
                for (int bj = 0; bj < 2; ++bj) { const int c = col0 + bj * 128; const f32x4 v0 = acc[ai][bj][m][0], v1 = acc[ai][bj][m][1];
                    const u32x4 gw = *(const u32x4*)(Gt + r * 2048 + (sub ? 1024 : 0) + c);
                    float o[8] = { v0[0] * bf_lo(gw.x), v0[1] * bf_hi(gw.x), v0[2] * bf_lo(gw.y), v0[3] * bf_hi(gw.y), v1[0] * bf_lo(gw.z), v1[1] * bf_hi(gw.z), v1[2] * bf_lo(gw.w), v1[3] * bf_hi(gw.w) };
                    if (sub) { const u32x4 tw = *(const u32x4*)(T + r * 1024 + c);
                        o[0] += bf_lo(tw.x); o[1] += bf_hi(tw.x); o[2] += bf_lo(tw.y); o[3] += bf_hi(tw.y); o[4] += bf_lo(tw.z); o[5] += bf_hi(tw.z); o[6] += bf_lo(tw.w); o[7] += bf_hi(tw.w); }
                    u32x4 w; w.x = cvt_pk_bf16(o[0], o[1]); w.y = cvt_pk_bf16(o[2], o[3]); w.z = cvt_pk_bf16(o[4], o[5]); w.w = cvt_pk_bf16(o[6], o[7]);
                    *(u32x4*)(T + ((long)(sub ? MRG_OFF : 0L) + (long)(r * 1024 + c))) = w; } }
    }
};
struct EpiRes {
    static constexpr bool AFTER_DRAIN = false;
    static constexpr bool PERM = false;
    const float *bp, *bs; float* out; const float* gate;
    __device__ __forceinline__ void operator()(const f32x4 (&acc)[2][2][4][2], const Unit& u, int wr, int wc, int fr, int fq) const {
        const int v = u.pm < 32 ? 0 : 1 + ((u.pm - 32) >> 2);
        const int col0 = u.pn * 256 + wc * 32 + 4 * fq;
        f32x4 gt[2][2];
#pragma unroll
        for (int bj = 0; bj < 2; ++bj)
#pragma unroll
            for (int n = 0; n < 2; ++n) gt[bj][n] = *(const f32x4*)(gate + (size_t)v * 6144 + col0 + bj * 128 + n * 16);
#pragma unroll
        for (int ai = 0; ai < 2; ++ai)
#pragma unroll
            for (int m = 0; m < 4; ++m) { const int r = u.pm * 256 + ai * 128 + wr * 64 + m * 16 + fr;
                const float* b = (u.pm < 32 ? bp + (size_t)r * 1024 : bs + (size_t)(r - NPROMPT) * 1024) + col0; float* o = out + (size_t)r * 1024 + col0;
#pragma unroll
                for (int bj = 0; bj < 2; ++bj)
#pragma unroll
                    for (int n = 0; n < 2; ++n) { const f32x4 x = *(const f32x4*)(b + bj * 128 + n * 16); *(f32x4*)(o + bj * 128 + n * 16) = x + gt[bj][n] * acc[ai][bj][m][n]; } }
    }
};
struct EpiResNorm {
    static constexpr bool PERM = false, AFTER_DRAIN = true;
    const float *bp, *bs; float* out; const float* gate; const float* A2; const float* S2; bf16_t* H2; float* xbuf; unsigned* cnt;
    __device__ __forceinline__ void operator()(const f32x4 (&)[2][2][4][2], const Unit&, int, int, int, int) const {}
    __device__ __forceinline__ void fused(f32x4 (&acc)[2][2][4][2], const Unit& u, int wr, int wc, int fr, int fq, LAS unsigned char* lds, int tid, int lane) const {
        const int v = u.pm < 32 ? 0 : 1 + ((u.pm - 32) >> 2);
        const int col0 = u.pn * 256 + wc * 32 + 4 * fq;
        LAS float* P = (LAS float*)lds; LAS float* S = P + 1024;
        { f32x4 gt[2][2];
#pragma unroll
          for (int bj = 0; bj < 2; ++bj)
#pragma unroll
            for (int n = 0; n < 2; ++n) gt[bj][n] = *(const f32x4*)(gate + (size_t)v * 6144 + col0 + bj * 128 + n * 16);
#pragma unroll
          for (int ai = 0; ai < 2; ++ai)
#pragma unroll
            for (int m = 0; m < 4; ++m) { const int r = u.pm * 256 + ai * 128 + wr * 64 + m * 16 + fr;
                const float* b = (u.pm < 32 ? bp + (size_t)r * 1024 : bs + (size_t)(r - NPROMPT) * 1024) + col0; float* o = out + (size_t)r * 1024 + col0;
                float ss = 0.f;
#pragma unroll
                for (int bj = 0; bj < 2; ++bj)
#pragma unroll
                    for (int n = 0; n < 2; ++n) { const f32x4 x = *(const f32x4*)(b + bj * 128 + n * 16); const f32x4 y = x + gt[bj][n] * acc[ai][bj][m][n];
                        acc[ai][bj][m][n] = y; *(f32x4*)(o + bj * 128 + n * 16) = y; ss += (y[0] * y[0] + y[1] * y[1]) + (y[2] * y[2] + y[3] * y[3]); }
                ss += __shfl_xor(ss, 16); ss += __shfl_xor(ss, 32);
                if (fq == 0) P[(ai * 128 + wr * 64 + m * 16 + fr) * 4 + wc] = ss; } }
        __syncthreads();
        if (tid < 256) { const f32x4 p = *(const LAS f32x4*)(P + tid * 4); xbuf[((size_t)u.pm * 256 + tid) * 4 + u.pn] = (p[0] + p[1]) + (p[2] + p[3]); }
        asm volatile("s_waitcnt vmcnt(0)" ::: "memory");
        __syncthreads();
        if (tid == 0) { unsigned* cw = cnt + 64 * u.pm; xb_add(cw, 1u);
            unsigned sp = 0; while (xb_ld(cw) < 4u) { __builtin_amdgcn_s_sleep(1); if (++sp > (1u << 22)) break; }
            __builtin_amdgcn_fence(__ATOMIC_ACQUIRE, "agent"); asm volatile("s_waitcnt vmcnt(0)" ::: "memory"); }
        __syncthreads();
        if (tid < 256) { const f32x4 p = *(const f32x4*)(xbuf + ((size_t)u.pm * 256 + tid) * 4); S[tid] = rsqrtf(((p[0] + p[1]) + (p[2] + p[3])) * (1.f / 1024.f) + 1e-6f); }
        __syncthreads();
#pragma unroll
        for (int ai = 0; ai < 2; ++ai)
#pragma unroll
            for (int m = 0; m < 4; ++m) { const int rl = ai * 128 + wr * 64 + m * 16 + fr; const float rstd = S[rl];
                bf16_t* hrow = H2 + (size_t)(u.pm * 256 + rl) * 1024 + col0;
#pragma unroll
                for (int bj = 0; bj < 2; ++bj)
#pragma unroll
                    for (int n = 0; n < 2; ++n) { const f32x4 a2 = *(const f32x4*)(A2 + (size_t)v * 1024 + col0 + bj * 128 + n * 16), s2 = *(const f32x4*)(S2 + (size_t)v * 1024 + col0 + bj * 128 + n * 16);
                        const f32x4 y = acc[ai][bj][m][n] * rstd * a2 + s2; u32x2 w; w.x = cvt_pk_bf16(y[0], y[1]); w.y = cvt_pk_bf16(y[2], y[3]); *(u32x2*)(hrow + bj * 128 + n * 16) = w; } }
    }
};
struct EpiSwiglu {
    static constexpr bool AFTER_DRAIN = false;
    static constexpr bool PERM = true;
    bf16_t* O;
    __device__ __forceinline__ void operator()(const f32x4 (&acc)[2][2][4][2], const Unit& u, int wr, int wc, int fr, int fq) const {
        const int row0 = u.pm * 256 + wr * 64 + fr, col0 = u.pn * 128 + wc * 32 + 8 * fq;
#pragma unroll
        for (int ai = 0; ai < 2; ++ai)
#pragma unroll
            for (int m = 0; m < 4; ++m) { float o[8];
#pragma unroll
                for (int n = 0; n < 2; ++n)
#pragma unroll
                    for (int j = 0; j < 4; ++j) { const float a = acc[ai][0][m][n][j], uu = acc[ai][1][m][n][j]; o[4 * n + j] = a * __builtin_amdgcn_rcpf(1.f + __expf(-a)) * uu; }
                u32x4 w; w.x = cvt_pk_bf16(o[0], o[1]); w.y = cvt_pk_bf16(o[2], o[3]); w.z = cvt_pk_bf16(o[4], o[5]); w.w = cvt_pk_bf16(o[6], o[7]);
                *(u32x4*)(O + (size_t)(row0 + ai * 128 + m * 16) * DFF + col0) = w; }
    }
};
}

constexpr int AT_P = 72;
constexpr int AT_KS = 0, AT_VT = 64 * AT_P * 2, AT_PW = 2 * 64 * AT_P * 2, AT_WB = 64 * AT_P * 2;
__device__ __forceinline__ void attn_unit(LAS unsigned char* lds, int unit, const bf16_t* Q, const bf16_t* Kb, const bf16_t* Vb, const bf16_t* CK, const bf16_t* CV,
                                          bf16_t* O, const float* sinks, int tid, int wave, int lane) {
    const int fr = lane & 15, fq = lane >> 4;
    int qrow_base, kvh, nb = 0, krow_base, crow_base = 0; bool lat;
    if (unit < 128) { const int b = unit >> 2; kvh = (unit >> 1) & 1; qrow_base = b * 256 + (unit & 1) * 128; krow_base = b * 256; lat = false; }
    else { const int u2 = unit - 128, b = u2 >> 4; kvh = (u2 >> 3) & 1; nb = u2 & 7; qrow_base = NPROMPT + b * 1024 + nb * 128; krow_base = NPROMPT + b * 1024; crow_base = b * 256; lat = true; }
    const int g = wave >> 1, th = wave & 1, h = kvh * 4 + g;
    const int qrow0 = qrow_base + th * 64;
    bf16x8 qf[4][2];
#pragma unroll
    for (int qi = 0; qi < 4; ++qi)
#pragma unroll
        for (int s = 0; s < 2; ++s) { const bf16_t* Qu = Q + (size_t)qrow0 * 512 + h * 64; qf[qi][s] = *(const bf16x8*)(Qu + (unsigned)((qi * 16 + fr) * 512 + s * 32 + fq * 8)); }
    const float L2E = 1.4426950408889634f, sc = 0.125f * L2E;
    float m_[4], l_[4]; const float sk = sinks[h] * L2E;
#pragma unroll
    for (int qi = 0; qi < 4; ++qi) { m_[qi] = sk; l_[qi] = (fq == 0) ? 1.f : 0.f; }
    f32x4 o[4][4];
#pragma unroll
    for (int a = 0; a < 4; ++a)
#pragma unroll
        for (int b = 0; b < 4; ++b) o[a][b] = (f32x4){0.f, 0.f, 0.f, 0.f};
    LAS unsigned char* Pw = lds + AT_PW + wave * AT_WB;
    const int ntl = lat ? 6 : 0, ntot = ntl + 4;
#define AT_TILE(t, KS_, VS_, KT_, OK_) do { OK_ = true; KT_ = 0; if ((t) < ntl) { KT_ = 128 * (nb - 1) + 64 * (t); if (KT_ < 0 || KT_ >= 1024) OK_ = false; \
            const size_t ro_ = (size_t)(krow_base + (OK_ ? KT_ : 0)) * 128; KS_ = Kb + ro_; VS_ = Vb + ro_; } \
        else { const size_t ro_ = (size_t)((lat ? crow_base : krow_base) + ((t) - ntl) * 64) * 128; KS_ = (lat ? CK : Kb) + ro_; VS_ = (lat ? CV : Vb) + ro_; } } while (0)
    int tcur = 0; const bf16_t *ksrc, *vsrc; int ktok0; bool ok;
    for (;; ++tcur) { AT_TILE(tcur, ksrc, vsrc, ktok0, ok); if (ok) break; }
    const unsigned kofs = (unsigned)((tid >> 3) * 128 + kvh * 64 + (tid & 7) * 8), vofs = (unsigned)(lane * 128 + kvh * 64 + wave * 8);
    u32x4 kreg = *(const u32x4*)(ksrc + kofs);
    u32x4 vreg = *(const u32x4*)(vsrc + vofs);
    while (tcur < ntot) {
        const bool masked = (tcur < ntl) && (tcur < 2 || tcur >= 4); const int ktokc = ktok0;
        __syncthreads();
        { const int key = tid >> 3, ch = tid & 7;
          *(LAS u32x4*)(lds + AT_KS + (key * AT_P + ch * 8) * 2) = kreg;
          LAS unsigned short* vt = (LAS unsigned short*)(lds + AT_VT) + (wave * 8) * AT_P + lane;
          vt[0 * AT_P] = (unsigned short)(vreg.x & 0xffffu); vt[1 * AT_P] = (unsigned short)(vreg.x >> 16);
          vt[2 * AT_P] = (unsigned short)(vreg.y & 0xffffu); vt[3 * AT_P] = (unsigned short)(vreg.y >> 16);
          vt[4 * AT_P] = (unsigned short)(vreg.z & 0xffffu); vt[5 * AT_P] = (unsigned short)(vreg.z >> 16);
          vt[6 * AT_P] = (unsigned short)(vreg.w & 0xffffu); vt[7 * AT_P] = (unsigned short)(vreg.w >> 16); }
        int tn = tcur + 1;
        for (; tn < ntot; ++tn) { AT_TILE(tn, ksrc, vsrc, ktok0, ok); if (ok) break; }
        if (tn < ntot) { kreg = *(const u32x4*)(ksrc + kofs); vreg = *(const u32x4*)(vsrc + vofs); }
        __syncthreads();
#pragma unroll
        for (int qh = 0; qh < 2; ++qh) {
        f32x4 st[4][2];
#pragma unroll
        for (int kb = 0; kb < 4; ++kb) {
            const bf16x8 k0 = *(const LAS bf16x8*)(lds + AT_KS + ((kb * 16 + fr) * AT_P + fq * 8) * 2), k1 = *(const LAS bf16x8*)(lds + AT_KS + ((kb * 16 + fr) * AT_P + 32 + fq * 8) * 2);
#pragma unroll
            for (int q2 = 0; q2 < 2; ++q2) { f32x4 a = (f32x4){0.f, 0.f, 0.f, 0.f};
                a = __builtin_amdgcn_mfma_f32_16x16x32_bf16(k0, qf[2 * qh + q2][0], a, 0, 0, 0); a = __builtin_amdgcn_mfma_f32_16x16x32_bf16(k1, qf[2 * qh + q2][1], a, 0, 0, 0); st[kb][q2] = a; }
        }
#pragma unroll
        for (int q2 = 0; q2 < 2; ++q2) { const int qi = 2 * qh + q2;
            float mx = -INFINITY;
            if (masked) { const int qt = nb * 128 + th * 64 + qi * 16 + fr;
#pragma unroll
                for (int kb = 0; kb < 4; ++kb)
#pragma unroll
                    for (int j = 0; j < 4; ++j) { const int d = qt - (ktokc + kb * 16 + fq * 4 + j); if (d > 128 || d < -128) st[kb][q2][j] = -INFINITY; } }
#pragma unroll
            for (int kb = 0; kb < 4; ++kb) mx = fmaxf(fmaxf(mx, fmaxf(st[kb][q2][0], st[kb][q2][1])), fmaxf(st[kb][q2][2], st[kb][q2][3]));
            mx = fmaxf(mx, __shfl_xor(mx, 16)); mx = fmaxf(mx, __shfl_xor(mx, 32));
            const float mnew = fmaxf(m_[qi], mx * sc), alpha = __builtin_amdgcn_exp2f(m_[qi] - mnew); m_[qi] = mnew;
            float rs = 0.f;
#pragma unroll
            for (int kb = 0; kb < 4; ++kb) { f32x4 p;
#pragma unroll
                for (int j = 0; j < 4; ++j) { p[j] = __builtin_amdgcn_exp2f(__builtin_fmaf(st[kb][q2][j], sc, -mnew)); rs += p[j]; }
                u32x2 w; w.x = cvt_pk_bf16(p[0], p[1]); w.y = cvt_pk_bf16(p[2], p[3]);
                *(LAS u32x2*)(Pw + ((qi * 16 + fr) * AT_P + kb * 16 + fq * 4) * 2) = w; }
            l_[qi] = l_[qi] * alpha + rs;
#pragma unroll
            for (int db = 0; db < 4; ++db) o[db][qi] = o[db][qi] * alpha;
        }
        __builtin_amdgcn_sched_barrier(0);
        }
        asm volatile("s_waitcnt lgkmcnt(0)" ::: "memory");
#pragma unroll
        for (int s2 = 0; s2 < 2; ++s2) {
            bf16x8 pf[4];
#pragma unroll
            for (int qi = 0; qi < 4; ++qi) pf[qi] = *(const LAS bf16x8*)(Pw + ((qi * 16 + fr) * AT_P + s2 * 32 + fq * 8) * 2);
#pragma unroll
            for (int db = 0; db < 4; ++db) { const bf16x8 vf = *(const LAS bf16x8*)(lds + AT_VT + ((db * 16 + fr) * AT_P + s2 * 32 + fq * 8) * 2);
#pragma unroll
                for (int qi = 0; qi < 4; ++qi) o[db][qi] = __builtin_amdgcn_mfma_f32_16x16x32_bf16(vf, pf[qi], o[db][qi], 0, 0, 0); }
        }
        tcur = tn;
    }
#undef AT_TILE
    int fr2 = lane & 15, fq2 = lane >> 4; asm volatile("" : "+v"(fr2), "+v"(fq2));
#pragma unroll
    for (int qi = 0; qi < 4; ++qi) { float lt = l_[qi]; lt += __shfl_xor(lt, 16); lt += __shfl_xor(lt, 32); const float inv = 1.f / lt;
        bf16_t* Ou = O + (size_t)qrow0 * 1536 + h * 64; bf16_t* dst = Ou + (unsigned)((qi * 16 + fr2) * 1536 + fq2 * 4);
#pragma unroll
        for (int db = 0; db < 4; ++db) { const f32x4 v = o[db][qi] * inv; u32x2 w; w.x = cvt_pk_bf16(v[0], v[1]); w.y = cvt_pk_bf16(v[2], v[3]); *(u32x2*)(dst + db * 16) = w; } }
}

__device__ __forceinline__ float wave_sum(float v) {
#pragma unroll
    for (int o = 1; o < 64; o <<= 1) v += __shfl_xor(v, o);
    return v;
}
__device__ __forceinline__ int dest_row(int c, int mode) {
    if (mode == 1) { if (c < 512 || c >= 1280) return c; const int c2 = c - 512, pn = c2 >> 8, a = c2 & 255, wc = a >> 6, bj = (a >> 5) & 1; return 512 + 256 * pn + 128 * bj + 32 * wc + (a & 31); }
    if (mode == 2) { if (c < DFF) return 256 * (c >> 7) + (c & 127); const int j = c - DFF; return 256 * (j >> 7) + 128 + (j & 127); }
    return c;
}
__device__ __forceinline__ void p0_transpose_item(const float* W, int K, int N, bf16_t* WT, int ldw, int koff, int mode, LAS float* scr, int item, int lane) {
    const int nblk = N / 32, kb = item / nblk, nbk = item % nblk, k0 = 64 * kb, n0 = 32 * nbk;
    const unsigned lo_ = (unsigned)((lane >> 5) * N + (lane & 31));
#pragma unroll
    for (int h = 0; h < 2; ++h) { float t[16];
#pragma unroll
        for (int i = 0; i < 16; ++i) { const float* rowp = W + (size_t)(k0 + 2 * (16 * h + i)) * N + n0; t[i] = rowp[lo_]; }
#pragma unroll
        for (int i = 0; i < 16; ++i) scr[(2 * (16 * h + i) + (lane >> 5)) * 33 + (lane & 31)] = t[i]; }
    asm volatile("s_waitcnt lgkmcnt(0)" ::: "memory");
    const int c = lane & 7; const int d0 = dest_row(n0, mode);
#pragma unroll
    for (int j = 0; j < 4; ++j) { const int n = (lane >> 3) + 8 * j; const LAS float* s = scr + (8 * c) * 33 + n;
        u32x4 o; o.x = f2bf(s[0 * 33]) | (f2bf(s[1 * 33]) << 16); o.y = f2bf(s[2 * 33]) | (f2bf(s[3 * 33]) << 16); o.z = f2bf(s[4 * 33]) | (f2bf(s[5 * 33]) << 16); o.w = f2bf(s[6 * 33]) | (f2bf(s[7 * 33]) << 16);
        *(u32x4*)(WT + (size_t)(d0 + n) * ldw + koff + k0 + 8 * c) = o; }
    asm volatile("s_waitcnt lgkmcnt(0)" ::: "memory");
}
__device__ __forceinline__ void p0_fold_item(const float* wf, bf16_t* Wcat, LAS float* scr, int item, int lane) {
    const int g = item >> 8, o0 = (item & 255) * 4;
    LAS float* tw = scr;
    LAS float* tc = scr + 512;
    LAS float* ts = scr + 640;
#pragma unroll
    for (int i = 0; i < 2; ++i) { const int l = lane + 64 * i; const f32x4 v = *(const f32x4*)(wf + (size_t)(g * 128 + l) * 1024 + o0); *(LAS f32x4*)(tw + l * 4) = v;
        tc[l] = cospif((float)l * (1.f / 64.f)); ts[l] = sinpif((float)l * (1.f / 64.f)); }
    asm volatile("s_waitcnt lgkmcnt(0)" ::: "memory");
    float ce[4], co[4], se[4], so[4];
#pragma unroll
    for (int j = 0; j < 4; ++j) { ce[j] = 0.f; co[j] = 0.f; se[j] = 0.f; so[j] = 0.f; }
    const int c = lane;
#pragma unroll 4
    for (int l = 0; l < 128; l += 2) {
        { const int idx = (l * c) & 127; const float cv = tc[idx], sv = ts[idx]; const f32x4 w = *(const LAS f32x4*)(tw + l * 4);
#pragma unroll
          for (int j = 0; j < 4; ++j) { ce[j] += cv * w[j]; se[j] += sv * w[j]; } }
        { const int idx = ((l + 1) * c) & 127; const float cv = tc[idx], sv = ts[idx]; const f32x4 w = *(const LAS f32x4*)(tw + (l + 1) * 4);
#pragma unroll
          for (int j = 0; j < 4; ++j) { co[j] += cv * w[j]; so[j] += sv * w[j]; } }
    }
    const float sc = 0.08838834764831845f;
#pragma unroll
    for (int j = 0; j < 4; ++j) { bf16_t* row = Wcat + (size_t)(o0 + j) * 1536 + g * 128;
        row[c] = (bf16_t)f2bf((ce[j] + co[j]) * sc); row[c + 64] = (bf16_t)f2bf((ce[j] - co[j]) * sc);
        row[512 + c] = (bf16_t)f2bf(-(se[j] + so[j]) * sc); row[512 + c + 64] = (bf16_t)f2bf(-(se[j] - so[j]) * sc); }
    asm volatile("s_waitcnt lgkmcnt(0)" ::: "memory");
}
__device__ __forceinline__ void p0_ada_item(const float* w_ada, const float* c_lat, const float* c_ctx, float* part, LAS float* scr, int item, int lane) {
    const int cc = item % 96, ic = item / 96, j = cc * 64 + lane, i0 = ic * 128;
#pragma unroll
    for (int v = 0; v < 9; ++v)
#pragma unroll
        for (int hh = 0; hh < 2; ++hh) { const int i = lane + 64 * hh; const float x = (v == 0) ? c_ctx[i0 + i] : c_lat[(v - 1) * 1024 + i0 + i]; scr[v * 128 + i] = x / (1.f + __expf(-x)); }
    asm volatile("s_waitcnt lgkmcnt(0)" ::: "memory");
    float acc[9];
#pragma unroll
    for (int v = 0; v < 9; ++v) acc[v] = 0.f;
#pragma unroll 1
    for (int i = 0; i < 128; i += 16) { float w[16];
#pragma unroll
        for (int q = 0; q < 16; ++q) { const float* rowp = w_ada + (size_t)(i0 + i + q) * 6144 + cc * 64; w[q] = rowp[lane]; }
#pragma unroll
        for (int q = 0; q < 16; q += 4)
#pragma unroll
            for (int v = 0; v < 9; ++v) { const f32x4 sv = *(const LAS f32x4*)(scr + v * 128 + i + q); acc[v] += (sv[0] * w[q] + sv[1] * w[q + 1]) + (sv[2] * w[q + 2] + sv[3] * w[q + 3]); } }
#pragma unroll
    for (int v = 0; v < 9; ++v) part[((size_t)ic * 9 + v) * 6144 + j] = acc[v];
    asm volatile("s_waitcnt lgkmcnt(0)" ::: "memory");
}

__device__ __forceinline__ void norm_chunk(LAS unsigned char* lds, int chunk, const float* xp, const float* xs, const float* gnorm, const float* modsrc, const float* b_ada, bool partials,
                                           int off_shift, int off_scale, bf16_t* out, int tid, int wave, int lane) {
    const int row0 = chunk * 64; const int v = row0 < NPROMPT ? 0 : 1 + ((row0 - NPROMPT) >> 10);
    LAS float* la = (LAS float*)lds; LAS float* ls = la + 1024;
    __syncthreads();
    for (int col = tid; col < 1024; col += 512) {
        float sc, sh;
        if (partials) { sc = b_ada[off_scale + col]; sh = b_ada[off_shift + col];
#pragma unroll
            for (int p = 0; p < 8; ++p) { sc += modsrc[((size_t)p * 9 + v) * 6144 + off_scale + col]; sh += modsrc[((size_t)p * 9 + v) * 6144 + off_shift + col]; } }
        else { sc = modsrc[(size_t)v * 6144 + off_scale + col]; sh = modsrc[(size_t)v * 6144 + off_shift + col]; }
        la[col] = gnorm[col] * (1.f + sc); ls[col] = sh;
    }
    __syncthreads();
    for (int rr = 0; rr < 8; ++rr) {
        const int row = row0 + wave * 8 + rr;
        const float* xr = row < NPROMPT ? xp + (size_t)row * 1024 : xs + (size_t)(row - NPROMPT) * 1024;
        f32x4 x[4]; float ss = 0.f;
#pragma unroll
        for (int j = 0; j < 4; ++j) { x[j] = *(const f32x4*)(xr + 4 * lane + 256 * j); ss += (x[j][0] * x[j][0] + x[j][1] * x[j][1]) + (x[j][2] * x[j][2] + x[j][3] * x[j][3]); }
        const float rstd = rsqrtf(wave_sum(ss) * (1.f / 1024.f) + 1e-6f);
#pragma unroll
        for (int j = 0; j < 4; ++j) { const f32x4 a = *(const LAS f32x4*)(la + 4 * lane + 256 * j), s = *(const LAS f32x4*)(ls + 4 * lane + 256 * j);
            const f32x4 y = x[j] * rstd * a + s; u32x2 w; w.x = cvt_pk_bf16(y[0], y[1]); w.y = cvt_pk_bf16(y[2], y[3]);
            *(u32x2*)(out + (size_t)row * 1024 + 4 * lane + 256 * j) = w; }
    }
}

#define XB_TMO      128
#define XB_XCNT(j)  (256  + 64 * (j))
#define XB_XSUB(j)  (1280 + 64 * (j))
#define XB_XGEN(j)  (2304 + 64 * (j))
#define XB_TOP      3328
#define XB_TOPGEN   3392
#define XCD_BAR_WORDS 3456
#define XB_SPIN_CAP (1u << 18)

__device__ __forceinline__ unsigned xb_xcc_id() { return (unsigned)__builtin_amdgcn_s_getreg((3 << 11) | 20) & 0xFu; }
#define XB_SPIN(cond, bar) do { unsigned _sp = 0; while (cond) { __builtin_amdgcn_s_sleep(1); \
    if ((++_sp & 255u) == 0u) { if (xb_ld(&(bar)[XB_TMO])) break; if (_sp > XB_SPIN_CAP) { atomicAdd(&(bar)[XB_TMO], 1u); break; } } } } while (0)

struct XcdBarrier {
    unsigned* bar; unsigned x;
    volatile LAS unsigned* st;
};

__device__ __forceinline__ XcdBarrier xcd_barrier_post(unsigned* bar, volatile LAS unsigned* st) {
    XcdBarrier b; b.bar = bar; b.x = xb_xcc_id(); b.st = st;
    if (threadIdx.x == 0) (void)xb_add(&bar[XB_XCNT(b.x)], 1u);
    return b;
}
__device__ __forceinline__ void xcd_barrier_complete(unsigned* bar, unsigned x, unsigned& nloc, unsigned& nx) {
    const unsigned G = gridDim.x * gridDim.y * gridDim.z;
    unsigned sum, cnt, mine, sp = 0u;
    for (;;) {
        sum = 0u; cnt = 0u; mine = 0u;
#pragma unroll
        for (unsigned j = 0; j < 16; ++j) { const unsigned c = xb_ld(&bar[XB_XCNT(j)]); sum += c; cnt += (c > 0u) ? 1u : 0u; mine = (j == x) ? c : mine; }
        if (sum == G) break;
        __builtin_amdgcn_s_sleep(1);
        if ((++sp & 255u) == 0u) { if (xb_ld(&bar[XB_TMO])) break; if (sp > XB_SPIN_CAP) { atomicAdd(&bar[XB_TMO], 1u); break; } }
    }
    nloc = mine > 0u ? mine : 1u; nx = cnt > 0u ? cnt : 1u;
}

__device__ __forceinline__ void xcd_barrier(const XcdBarrier& b) {
    asm volatile("s_waitcnt vmcnt(0)" ::: "memory");
    __syncthreads();
    if (threadIdx.x == 0) {
        unsigned* bar = b.bar;
        __builtin_amdgcn_s_waitcnt(0);
        unsigned nloc = b.st[0], nx = b.st[1];
        if (nloc == 0u) { xcd_barrier_complete(bar, b.x, nloc, nx); b.st[0] = nloc; b.st[1] = nx; }
        const unsigned old = xb_add(&bar[XB_XSUB(b.x)], 1u);
        const unsigned gen = old / nloc;
        if (old + 1u == (gen + 1u) * nloc) {
            __builtin_amdgcn_fence(__ATOMIC_RELEASE, "agent");
            asm volatile("s_waitcnt vmcnt(0)" ::: "memory");
            const unsigned og = xb_add(&bar[XB_TOP], 1u);
            const unsigned tg = og / nx;
            if (og + 1u == (tg + 1u) * nx) xb_add(&bar[XB_TOPGEN], 1u);
            else XB_SPIN(xb_ld(&bar[XB_TOPGEN]) == tg, bar);
            __builtin_amdgcn_fence(__ATOMIC_ACQUIRE, "agent");
            xb_add(&bar[XB_XGEN(b.x)], 1u);
            asm volatile("s_waitcnt vmcnt(0)" ::: "memory");
        } else {
            XB_SPIN(xb_ld(&bar[XB_XGEN(b.x)]) == gen, bar);
            __builtin_amdgcn_fence(__ATOMIC_ACQUIRE, "agent");
            asm volatile("s_waitcnt vmcnt(0)" ::: "memory");
        }
    }
    __syncthreads();
}

#define XL_SUB(j) (3456 + 64 * (j))
#define XL_GEN(j) (3456 + 1024 + 64 * (j))
__device__ __forceinline__ void xcd_local_barrier(const XcdBarrier& b) {
    asm volatile("s_waitcnt vmcnt(0)" ::: "memory");
    __syncthreads();
    if (threadIdx.x == 0) {
        unsigned* bar = b.bar; const unsigned nloc = b.st[0];
        const unsigned old = xb_add(&bar[XL_SUB(b.x)], 1u), gen = old / nloc;
        if (old + 1u == (gen + 1u) * nloc) xb_add(&bar[XL_GEN(b.x)], 1u);
        else XB_SPIN(xb_ld(&bar[XL_GEN(b.x)]) == gen, bar);
        __builtin_amdgcn_fence(__ATOMIC_ACQUIRE, "agent");
        asm volatile("s_waitcnt vmcnt(0)" ::: "memory");
    }
    __syncthreads();
}

struct Args { const float* in[19]; float* out; unsigned char* ws; int ph_lo, ph_hi; };
#ifndef MK_LAST
#define MK_LAST 9
#endif
constexpr int NPH = MK_LAST;

__global__ void __launch_bounds__(512, 2) mk_fwd(Args args) {
    extern __shared__ __attribute__((aligned(16))) unsigned char lds_raw[];
    LAS unsigned char* lds = (LAS unsigned char*)lds_raw;
    const int tid = threadIdx.x, lane = tid & 63, wave = __builtin_amdgcn_readfirstlane(tid >> 6);
    const int G = gridDim.x;
    unsigned char* ws = args.ws;
    const float* x_prompt = args.in[0]; const float* x_sample = args.in[1]; const float* cache_k = args.in[2]; const float* cache_v = args.in[3];
    const float* c_lat = args.in[4]; const float* c_ctx = args.in[5]; const float* w_ada = args.in[6]; const float* b_ada = args.in[7];
    const float* g_norm1 = args.in[8]; const float* g_norm2 = args.in[9]; const float* w_in = args.in[10]; const float* g_q = args.in[11]; const float* g_k = args.in[12];
    const float* sinks = args.in[13]; const float* w_f = args.in[14]; const float* w_ao = args.in[15]; const float* w_out = args.in[16]; const float* w_up = args.in[17]; const float* w_down = args.in[18];
    float* out = args.out;
    float* modp = (float*)(ws + WS_MODP); float* mod = (float*)(ws + WS_MOD); float* modA2 = (float*)(ws + WS_MOD + 256 * 1024); float* modS2 = modA2 + 9 * 1024; float* ropeC = (float*)(ws + WS_ROPE); float* ropeS = ropeC + 1024;
    bf16_t* Win = (bf16_t*)(ws + WS_WIN); bf16_t* Wcat = (bf16_t*)(ws + WS_WCAT); bf16_t* Wout = (bf16_t*)(ws + WS_WOUT); bf16_t* Wup = (bf16_t*)(ws + WS_WUP); bf16_t* Wdn = (bf16_t*)(ws + WS_WDN);
    bf16_t* Dft = (bf16_t*)(ws + WS_DFT); bf16_t* CK = (bf16_t*)(ws + WS_CK); bf16_t* CV = (bf16_t*)(ws + WS_CV);
    bf16_t* Hb = (bf16_t*)(ws + WS_H); bf16_t* ZT = (bf16_t*)(ws + WS_ZFT); bf16_t* Qb = (bf16_t*)(ws + WS_Q); bf16_t* Kb = (bf16_t*)(ws + WS_K); bf16_t* Vb = (bf16_t*)(ws + WS_V);
    bf16_t* Gt = (bf16_t*)(ws + WS_G); bf16_t* ABX = (bf16_t*)(ws + WS_ABX); bf16_t* Tb = (bf16_t*)(ws + WS_T); bf16_t* ACT = (bf16_t*)(ws + WS_ACT);
    float* out_ck = out + (size_t)MTOK * DM; float* out_cv = out_ck + (size_t)NPROMPT * 128;
    cg::grid_group grid = cg::this_grid();
    const int lo = args.ph_lo, hi = args.ph_hi;
#ifndef MK_REPEAT_MASK
#define MK_REPEAT_MASK 0
#endif
#if (MK_REPEAT_MASK >> 0) & 1
#define PH0 for (int rep_ = 0; rep_ < 2; ++rep_) if (IN(0))
#else
#define PH0 if (IN(0))
#endif
#if (MK_REPEAT_MASK >> 1) & 1
#define PH1 for (int rep_ = 0; rep_ < 2; ++rep_) if (IN(1))
#else
#define PH1 if (IN(1))
#endif
#if (MK_REPEAT_MASK >> 2) & 1
#define PH2 for (int rep_ = 0; rep_ < 2; ++rep_) if (IN(2))
#else
#define PH2 if (IN(2))
#endif
#if (MK_REPEAT_MASK >> 3) & 1
#define PH3 for (int rep_ = 0; rep_ < 2; ++rep_) if (IN(3))
#else
#define PH3 if (IN(3))
#endif
#if (MK_REPEAT_MASK >> 4) & 1
#define PH4 for (int rep_ = 0; rep_ < 2; ++rep_) if (IN(4))
#else
#define PH4 if (IN(4))
#endif
#if (MK_REPEAT_MASK >> 5) & 1
#define PH5 for (int rep_ = 0; rep_ < 2; ++rep_) if (IN(5))
#else
#define PH5 if (IN(5))
#endif
#if (MK_REPEAT_MASK >> 6) & 1
#define PH6 for (int rep_ = 0; rep_ < 2; ++rep_) if (IN(6))
#else
#define PH6 if (IN(6))
#endif
#if (MK_REPEAT_MASK >> 7) & 1
#define PH7 for (int rep_ = 0; rep_ < 2; ++rep_) if (IN(7))
#else
#define PH7 if (IN(7))
#endif
#define NREP(k) ((((MK_REPEAT_MASK) >> (k)) & 1) ? 2 : 1)
#define IN(k) (lo <= (k) && (k) < hi)
#define SEAM(k) do { if (IN(k) && IN((k) + 1)) xcd_barrier(bar); } while (0)
#define SEAM_L(k) do { if (IN(k) && IN((k) + 1)) { if (uni) xcd_local_barrier(bar); else xcd_barrier(bar); } } while (0)
    volatile LAS unsigned* bst = (volatile LAS unsigned*)(lds + 131072 + 1024);
    XcdBarrier bar; bar.bar = (unsigned*)ws; bar.x = xb_xcc_id(); bar.st = bst;
    if (tid == 0) {
        const unsigned rk = xb_add(&bar.bar[XB_XCNT(bar.x)], 1u);
        unsigned nloc, nx; xcd_barrier_complete(bar.bar, bar.x, nloc, nx);
        bool uni = (G == 256) && (bar.x < 8u);
        for (unsigned j = 0; j < 8; ++j) uni = uni && (xb_ld(&bar.bar[XB_XCNT(j)]) == 32u);
        bst[0] = nloc; bst[1] = nx; bst[2] = uni ? (rk * 8u + bar.x) : (unsigned)blockIdx.x; bst[3] = uni ? 1u : 0u; bst[4] = uni ? (bar.x * 32u + rk) : (unsigned)blockIdx.x;
    }
    __syncthreads();
    const int c = (int)bst[2];
    const bool uni = bst[3] != 0u;
    const int crow = (int)bst[4];
    if (lo < 0) grid.sync();

    if (NREP(10) == 2) { for (int i_ = 0; i_ < 8; ++i_) xcd_barrier(bar); }
    PH0 {
        LAS float* scr = (LAS float*)(lds + wave * 16384);
        const int gw = c * 8 + wave, NGW = G * 8;
        constexpr int I_ADA = 768, I_FOLD = 1024, I_IN = 16 * (INW / 32), I_AO = 8 * 32, I_OUT = 16 * 32, I_UP = 16 * (2 * DFF / 32), I_DN = (DFF / 64) * 32;
        constexpr int NITEMS = I_ADA + I_FOLD + I_IN + I_AO + I_OUT + I_UP + I_DN;
        for (int it = gw; it < NITEMS; it += NGW) {
            int r = it;
            if (r < I_ADA) { p0_ada_item(w_ada, c_lat, c_ctx, modp, scr, r, lane); continue; } r -= I_ADA;
            if (r < I_FOLD) { p0_fold_item(w_f, Wcat, scr, r, lane); continue; } r -= I_FOLD;
            const float* W; int K, N, ldw, koff, mode; bf16_t* WT;
            if (r < I_IN) { W = w_in; K = 1024; N = INW; WT = Win; ldw = 1024; koff = 0; mode = 1; }
            else if ((r -= I_IN) < I_AO) { W = w_ao; K = 512; N = 1024; WT = Wcat; ldw = 1536; koff = 1024; mode = 0; }
            else if ((r -= I_AO) < I_OUT) { W = w_out; K = 1024; N = 1024; WT = Wout; ldw = 1024; koff = 0; mode = 0; }
            else if ((r -= I_OUT) < I_UP) { W = w_up; K = 1024; N = 2 * DFF; WT = Wup; ldw = 1024; koff = 0; mode = 2; }
            else { r -= I_UP; W = w_down; K = DFF; N = 1024; WT = Wdn; ldw = DFF; koff = 0; mode = 0; }
            p0_transpose_item(W, K, N, WT, ldw, koff, mode, scr, r, lane);
        }
        const int gt = c * 512 + tid, NGT = G * 512;
        for (int e = gt; e < 1024 * 1024; e += NGT) { const int k = e >> 10, n = e & 1023, idx = (k * n) & 1023; const float a = (float)idx * (1.f / 512.f);
            Dft[e] = (bf16_t)f2bf(cospif(a) * (1.f / 32.f)); Dft[1024 * 1024 + e] = (bf16_t)f2bf(sinpif(a) * (1.f / 32.f)); }
        for (int e = gt; e < 256 * 256; e += NGT) { const int k = e >> 8, n = e & 255, idx = (k * n) & 255; const float a = (float)idx * (1.f / 128.f);
            Dft[2 * 1024 * 1024 + k * 1024 + n] = (bf16_t)f2bf(cospif(a) * (1.f / 16.f)); Dft[2 * 1024 * 1024 + 256 * 1024 + k * 1024 + n] = (bf16_t)f2bf(sinpif(a) * (1.f / 16.f)); }
        for (int e = gt; e < 2048 * 128 / 4; e += NGT) { const f32x4 kx = *(const f32x4*)(cache_k + 4 * (size_t)e), vx = *(const f32x4*)(cache_v + 4 * (size_t)e);
            u32x2 w; w.x = cvt_pk_bf16(kx[0], kx[1]); w.y = cvt_pk_bf16(kx[2], kx[3]); *(u32x2*)(CK + 4 * (size_t)e) = w;
            w.x = cvt_pk_bf16(vx[0], vx[1]); w.y = cvt_pk_bf16(vx[2], vx[3]); *(u32x2*)(CV + 4 * (size_t)e) = w; }
        for (int e = gt; e < 1024; e += NGT) { const int pos = e >> 4, i = e & 15; const float inv = powf(10000.f, -(float)i * (1.f / 16.f)); const float ang = (float)pos * inv;
            ropeC[e] = cosf(ang); ropeS[e] = sinf(ang); }
    }
    SEAM(0);
    if (IN(1)) {
        for (int e = c * 512 + tid; e < 9 * 6144; e += G * 512) { const int v = e / 6144, j = e % 6144; float s = b_ada[j];
#pragma unroll
            for (int p = 0; p < 8; ++p) s += modp[((size_t)p * 9 + v) * 6144 + j];
            mod[e] = s; }
        for (int e = c * 512 + tid; e < 9 * 1024; e += G * 512) { const int v = e >> 10, col = e & 1023; float sc = b_ada[4096 + col], sh = b_ada[3072 + col];
#pragma unroll
            for (int p = 0; p < 8; ++p) { sc += modp[((size_t)p * 9 + v) * 6144 + 4096 + col]; sh += modp[((size_t)p * 9 + v) * 6144 + 3072 + col]; }
            modA2[e] = g_norm2[col] * (1.f + sc); modS2[e] = sh; }
        for (int ch = crow; ch < 256 * NREP(1); ch += G) norm_chunk(lds, ch & 255, x_prompt, x_sample, g_norm1, modp, b_ada, true, 0, 1024, Hb, tid, wave, lane);
        __syncthreads();
    }
    SEAM_L(1);
    if (IN(2)) {
        pg8::SchedP2 S{G, c, (const char*)Hb, (const char*)Win, NREP(2)};
        pg8::EpiP2 E{Qb, Kb, Vb, Gt, ZT, out_ck, out_cv, g_q, g_k, ropeC, ropeS};
        pg8::gemm_phase<pg8::EpiP2, pg8::SchedP2>(lds, 1024, 1024, S, E);
    }
    SEAM(2);
    if (IN(3)) {
        pg8::SchedDft S{G, c, (const char*)Dft, (const char*)ZT, NREP(3)};
        pg8::EpiStore E{ABX, 1536};
        pg8::gemm_phase<pg8::EpiStore, pg8::SchedDft>(lds, 1024, 16384, S, E);
        if (c < 256) attn_unit(lds, c, Qb, Kb, Vb, CK, CV, ABX + 1024, sinks, tid, wave, lane);
        __syncthreads();
    }
    SEAM(3);
#ifdef MK_DBG
    if (IN(4)) {
        for (size_t e = (size_t)c * 512 + tid; e < (size_t)MTOK * 1024; e += (size_t)G * 512) { const size_t r = e >> 10; const int cc = (int)(e & 1023);
            float v = 0.f;
            if (MK_DBG == 1) v = bf_lo(ABX[r * 1536 + cc]);
            else if (MK_DBG == 2) v = cc < 512 ? bf_lo(ABX[r * 1536 + 1024 + cc]) : 0.f;
            else if (MK_DBG == 4) v = (cc < 512 && r < 8192) ? bf_lo(ABX[r * 1536 + 1024 + cc]) : 0.f;
            else if (MK_DBG == 3) v = cc < 512 ? bf_lo(Qb[r * 512 + cc]) : (cc < 640 ? bf_lo(Kb[r * 128 + cc - 512]) : (cc < 768 ? bf_lo(Vb[r * 128 + cc - 640]) : (r < 2048 ? (cc < 896 ? bf_lo(CK[r * 128 + cc - 768]) : bf_lo(CV[r * 128 + cc - 896])) : 0.f)));
            out[e] = v; }
    }
#else
    if (IN(4)) {
        pg8::SchedP4 S{G, c, (const char*)ABX, (const char*)Wcat, NREP(4)};
        pg8::EpiP4 E{Tb, Gt};
        pg8::gemm_phase<pg8::EpiP4, pg8::SchedP4>(lds, 1536, 1536, S, E);
    }
#endif
    SEAM_L(4);
    bf16_t* H2 = uni ? Tb : Hb;
    if (IN(5)) {
        pg8::SchedGrid S{G, c, 64, 4, 16, (const char*)Hb, (const char*)Wout, (size_t)256 * 1024 * 2, (size_t)256 * 1024 * 2, NREP(5)};
        if (uni) {
            pg8::EpiResNorm E{x_prompt, x_sample, out, mod + 2048, modA2, modS2, Tb, (float*)(ws + 512 * 1024), (unsigned*)ws + 6144};
            pg8::gemm_phase<pg8::EpiResNorm, pg8::SchedGrid>(lds, 1024, 1024, S, E);
        } else {
            pg8::EpiRes E{x_prompt, x_sample, out, mod + 2048};
            pg8::gemm_phase<pg8::EpiRes, pg8::SchedGrid>(lds, 1024, 1024, S, E);
        }
    }
    SEAM_L(5);
    if (IN(6) && !uni) {
        for (int ch = crow; ch < 256 * NREP(6); ch += G) norm_chunk(lds, ch & 255, out, out + (size_t)NPROMPT * 1024, g_norm2, mod, b_ada, false, 3072, 4096, Hb, tid, wave, lane);
        __syncthreads();
    }
    if (!uni) SEAM_L(6);
    if (IN(7)) {
        pg8::SchedGrid S{G, c, 64, 22, 16, (const char*)H2, (const char*)Wup, (size_t)256 * 1024 * 2, (size_t)256 * 1024 * 2, NREP(7)};
        pg8::EpiSwiglu E{ACT};
        pg8::gemm_phase<pg8::EpiSwiglu, pg8::SchedGrid>(lds, 1024, 1024, S, E);
    }
    SEAM_L(7);
    if (IN(8)) {
        pg8::SchedGrid S{G, c, 64, 4, DFF / 64, (const char*)ACT, (const char*)Wdn, (size_t)256 * DFF * 2, (size_t)256 * DFF * 2, 1};
        pg8::EpiRes E{out, out + (size_t)NPROMPT * 1024, out, mod + 5120};
#if (MK_REPEAT_MASK >> 8) & 1
        { pg8::EpiRes E2{out, out + (size_t)NPROMPT * 1024, (float*)(ws + WS_ABX), mod + 5120}; pg8::gemm_phase<pg8::EpiRes, pg8::SchedGrid>(lds, DFF, DFF, S, E2); }
#endif
        pg8::gemm_phase<pg8::EpiRes, pg8::SchedGrid>(lds, DFF, DFF, S, E);
    }
#undef IN
#undef SEAM
}

extern "C" void kernel_launch(void* const* d_in, const int* in_sizes, int n_in, void* d_out, int out_size, void* d_ws, size_t ws_size, hipStream_t stream) {
    static int grid = 0;
    if (grid == 0) {
        int dev = 0, cus = 0, per_cu = 0;
        if (n_in != 19 || ws_size < 256 * MiB) { fprintf(stderr, "kernel_launch: unexpected n_in %d / ws_size %zu\n", n_in, ws_size); grid = -1; return; }
        (void)hipGetDevice(&dev);
        (void)hipDeviceGetAttribute(&cus, hipDeviceAttributeMultiprocessorCount, dev);
        if (hipFuncSetAttribute((const void*)mk_fwd, hipFuncAttributeMaxDynamicSharedMemorySize, LDS_BYTES) != hipSuccess) { fprintf(stderr, "kernel_launch: hipFuncSetAttribute failed\n"); grid = -1; return; }
        if (hipOccupancyMaxActiveBlocksPerMultiprocessor(&per_cu, (const void*)mk_fwd, 512, LDS_BYTES) != hipSuccess || per_cu < 1) { fprintf(stderr, "kernel_launch: occupancy query gives %d\n", per_cu); per_cu = 1; (void)hipGetLastError(); }
        grid = cus * 1;
        if (grid > 256) grid = 256;
        if (grid != 256) { fprintf(stderr, "kernel_launch: this kernel needs 256 CUs (got %d)\n", grid); grid = -1; return; }
    }
    if (grid < 0) return;
    if (hipMemsetAsync(d_ws, 0, 65536, stream) != hipSuccess) { fprintf(stderr, "kernel_launch: memset failed\n"); return; }
    Args a{};
    for (int i = 0; i < 19; ++i) a.in[i] = (const float*)d_in[i];
    a.out = (float*)d_out; a.ws = (unsigned char*)d_ws;
    for (int li = 0; li < (MK_N_LAUNCHES == 1 ? 1 : NPH); ++li) {
        a.ph_lo = (MK_N_LAUNCHES == 1) ? 0 : li; a.ph_hi = (MK_N_LAUNCHES == 1) ? NPH : li + 1;
        void* kargs[] = {&a};
        hipError_t e = hipLaunchCooperativeKernel((const void*)mk_fwd, dim3(grid), dim3(512), kargs, LDS_BYTES, stream);
        if (e != hipSuccess) { fprintf(stderr, "kernel_launch: cooperative launch failed: %s (grid %d)\n", hipGetErrorString(e), grid); break; }
    }
}
```

```cpp
#include <hip/hip_runtime.h>
#include <hip/hip_cooperative_groups.h>
#include <cstdio>
#include <cstdint>
namespace cg = cooperative_groups;

#ifndef MK_N_LAUNCHES
#define MK_N_LAUNCHES 1
#endif

#define LAS __attribute__((address_space(3)))
typedef unsigned short bf16_t;
typedef short bf16x8 __attribute__((ext_vector_type(8)));
typedef float f32x4 __attribute__((ext_vector_type(4)));
typedef unsigned u32x4 __attribute__((ext_vector_type(4)));
typedef unsigned u32x2 __attribute__((ext_vector_type(2)));

typedef float f32x2_t __attribute__((ext_vector_type(2))); typedef __bf16 bf16x2_t __attribute__((ext_vector_type(2)));
__device__ __forceinline__ unsigned cvt_pk_bf16(float lo, float hi) { f32x2_t v = {lo, hi}; bf16x2_t b = __builtin_convertvector(v, bf16x2_t); return __builtin_bit_cast(unsigned, b); }
__device__ __forceinline__ float bf_lo(unsigned w) { return __uint_as_float(w << 16); }
__device__ __forceinline__ float bf_hi(unsigned w) { return __uint_as_float(w & 0xffff0000u); }
__device__ __forceinline__ unsigned f2bf(float f) { unsigned u = __float_as_uint(f); return (u + 0x7fffu + ((u >> 16) & 1u)) >> 16; }

constexpr int DM = 1024, MTOK = 16384, NPROMPT = 8192;
constexpr int INW = 3328, DFF = 2816;
constexpr size_t MiB = 1u << 20;
constexpr size_t WS_MODP = 1 * MiB;
constexpr size_t WS_MOD = 3 * MiB;
constexpr size_t WS_ROPE = 3 * MiB + 512 * 1024;
constexpr size_t WS_WIN = 4 * MiB;
constexpr size_t WS_WCAT = 11 * MiB;
constexpr size_t WS_WOUT = 14 * MiB;
constexpr size_t WS_WUP = 16 * MiB;
constexpr size_t WS_WDN = 27 * MiB;
constexpr size_t WS_DFT = 33 * MiB;
constexpr size_t WS_CK = 38 * MiB, WS_CV = 38 * MiB + 512 * 1024;
constexpr size_t WS_H = 40 * MiB;
constexpr size_t WS_ZFT = 72 * MiB;
constexpr size_t WS_Q = 88 * MiB;
constexpr size_t WS_K = 104 * MiB, WS_V = 108 * MiB;
constexpr size_t WS_G = 112 * MiB;
constexpr size_t WS_ABX = 176 * MiB;
constexpr size_t WS_T = 224 * MiB;
constexpr size_t WS_ACT = 72 * MiB;
constexpr int LDS_BYTES = 147456;

namespace pg8 {
constexpr int BM = 256, BK = 64, HALF = 128, HTB = HALF * BK * 2, STAGE_BYTES = 8 * HTB, NXCD = 8, WGM = 8;
__host__ __device__ __forceinline__ int lds_byte(int r, int c) { const int st = (r >> 4) * 2 + (c >> 5), rr = r & 15, cc = c & 31, ob = rr * 64 + cc * 2; return st * 1024 + (ob ^ (((ob >> 9) & 1) << 5)); }
__host__ __device__ __forceinline__ void stage_rc(int b, int& R, int& C) { const int st = b / 1024, sb = b % 1024, swz = sb ^ (((sb >> 9) & 1) << 5); R = (st >> 1) * 16 + swz / 64; C = (st & 1) * 32 + (swz % 64) / 2; }
__host__ __device__ __forceinline__ int perm32(int rho) { const int n = rho >> 4, i = rho & 15; return 8 * (i >> 2) + 4 * n + (i & 3); }

struct Unit { const char* A; const char* B; int nt, pm, pn, tag; };

__device__ __forceinline__ void tile_of(int L, int nM, int nN, int& pm, int& pn) {
    const int nwg = nM * nN; int wgid = L;
    { const int q = nwg / NXCD, r = nwg % NXCD, xcd = wgid % NXCD, off = wgid / NXCD; wgid = (xcd < r ? xcd * (q + 1) : r * (q + 1) + (xcd - r) * q) + off; }
    const int nig = WGM * nN, gid = wgid / nig, fm = gid * WGM, gsz = (nM - fm) < WGM ? (nM - fm) : WGM;
    pm = fm + ((wgid % nig) % gsz); pn = (wgid % nig) / gsz;
}

template <class Epi, class Sched>
__device__ __forceinline__ void gemm_phase(LAS unsigned char* lds, const int lda, const int ldb, const Sched& S, const Epi& E) {
    const int tid = threadIdx.x, wid = __builtin_amdgcn_readfirstlane(tid >> 6), lane = tid & 63, wr = wid >> 2, wc = wid & 3, fr = lane & 15, fq = lane >> 4;
    unsigned voffA[2], voffB[2];
#pragma unroll
    for (int i = 0; i < 2; ++i) { int R, C; stage_rc(tid * 16 + i * 8192, R, C); const int Rb = Epi::PERM ? ((R & ~31) + perm32(R & 31)) : R;
        voffA[i] = (unsigned)(R * lda + C) * 2u; voffB[i] = (unsigned)(Rb * ldb + C) * 2u; }
    const size_t kstep = (size_t)(BK * 2);
    const size_t hstepA = (size_t)HALF * lda * 2, hstepB = (size_t)HALF * ldb * 2;
    const unsigned ldsw = (unsigned)wid * 1024u;
    const int aoff = lds_byte(wr * 64 + fr, fq * 8), boff = lds_byte(wc * 32 + fr, fq * 8);
#define PG8_SA(b, h) (((b) * 2 + (h)) * HTB)
#define PG8_SB(b, h) ((4 + (b) * 2 + (h)) * HTB)
#define PG8_STAGE(bufoff, gbase, voff) do { _Pragma("unroll") for (int _i = 0; _i < 2; ++_i) \
        __builtin_amdgcn_global_load_lds((const unsigned*)((const char*)(gbase) + (voff)[_i]), (LAS unsigned*)(lds + (bufoff) + ldsw + _i * 8192), 16, 0, 0); } while (0)
#define PG8_LDA(dst, b, h) do { _Pragma("unroll") for (int m = 0; m < 4; ++m) _Pragma("unroll") for (int k = 0; k < 2; ++k) dst[m][k] = *(const LAS bf16x8*)(lds + PG8_SA(b, h) + aoff + m * 2048 + k * 1024); } while (0)
#define PG8_LDB(dst, b, h) do { _Pragma("unroll") for (int n = 0; n < 2; ++n) _Pragma("unroll") for (int k = 0; k < 2; ++k) dst[n][k] = *(const LAS bf16x8*)(lds + PG8_SB(b, h) + boff + n * 2048 + k * 1024); } while (0)
#define PG8_MMA(ai, bj, At, Bt) do { __builtin_amdgcn_s_setprio(1); _Pragma("unroll") for (int m = 0; m < 4; ++m) _Pragma("unroll") for (int n = 0; n < 2; ++n) _Pragma("unroll") for (int k = 0; k < 2; ++k) \
        acc[ai][bj][m][n] = __builtin_amdgcn_mfma_f32_16x16x32_bf16(Bt[n][k], At[m][k], acc[ai][bj][m][n], 0, 0, 0); __builtin_amdgcn_s_setprio(0); } while (0)
#define PG8_WAIT_V(n) asm volatile("s_waitcnt vmcnt(" #n ")" ::: "memory")
#define PG8_WAIT_L(n) asm volatile("s_waitcnt lgkmcnt(" #n ")" ::: "memory")
#define PG8_BAR __builtin_amdgcn_s_barrier()
#define PG8_SCHED __builtin_amdgcn_sched_barrier(0)
    Unit cur, nxt; int ui = 0;
    if (!S.next(0, cur)) return;
    f32x4 acc[2][2][4][2];
#pragma unroll
    for (int a = 0; a < 2; ++a)
#pragma unroll
        for (int b = 0; b < 2; ++b)
#pragma unroll
            for (int m = 0; m < 4; ++m)
#pragma unroll
                for (int n = 0; n < 2; ++n) acc[a][b][m][n] = (f32x4){0.f, 0.f, 0.f, 0.f};
    bf16x8 At[4][2], B0[2][2], B1[2][2];
    const char* cA = cur.A; const char* cB = cur.B;
    PG8_STAGE(PG8_SB(0, 0), cB, voffB); PG8_STAGE(PG8_SB(0, 1), cB + hstepB, voffB); PG8_STAGE(PG8_SA(0, 0), cA, voffA); PG8_STAGE(PG8_SA(0, 1), cA + hstepA, voffA);
    if (wr == 1) PG8_BAR;
    PG8_WAIT_V(2); PG8_BAR;
    PG8_STAGE(PG8_SB(1, 0), cB + kstep, voffB); PG8_STAGE(PG8_SA(1, 0), cA + kstep, voffA); PG8_STAGE(PG8_SB(1, 1), cB + hstepB + kstep, voffB);
    PG8_WAIT_V(6); PG8_BAR;
    for (;;) {
        const bool has_next = S.next(ui + 1, nxt);
        const char* nA = has_next ? nxt.A : cA; const char* nB = has_next ? nxt.B : cB;
        const int nt = cur.nt;
        for (int t = 0; t < nt; t += 2) {
            const bool last = (t == nt - 2);
            const char* a1 = cA + (size_t)(t + 1) * kstep;
            const char* a2 = last ? nA : cA + (size_t)(t + 2) * kstep; const char* b2 = last ? nB : cB + (size_t)(t + 2) * kstep;
            const char* a3 = a2 + kstep; const char* b3 = b2 + kstep;
            PG8_LDB(B0, 0, 0); PG8_LDB(B1, 0, 1); PG8_SCHED; PG8_LDA(At, 0, 0); PG8_STAGE(PG8_SA(1, 1), a1 + hstepA, voffA);
            PG8_WAIT_V(8); PG8_WAIT_L(0); PG8_BAR; PG8_MMA(0, 0, At, B0); PG8_MMA(0, 1, At, B1); PG8_BAR; PG8_SCHED;
            PG8_LDA(At, 0, 1); PG8_STAGE(PG8_SB(0, 0), b2, voffB); PG8_STAGE(PG8_SB(0, 1), b2 + hstepB, voffB); PG8_STAGE(PG8_SA(0, 0), a2, voffA);
            PG8_WAIT_V(8); PG8_WAIT_L(0); PG8_BAR; PG8_MMA(1, 0, At, B0); PG8_MMA(1, 1, At, B1); PG8_BAR; PG8_SCHED;
            PG8_LDB(B0, 1, 0); PG8_LDB(B1, 1, 1); PG8_SCHED; PG8_LDA(At, 1, 0); PG8_STAGE(PG8_SA(0, 1), a2 + hstepA, voffA);
            PG8_WAIT_V(8); PG8_WAIT_L(0); PG8_BAR; PG8_MMA(0, 0, At, B0); PG8_MMA(0, 1, At, B1); PG8_BAR; PG8_SCHED;
            PG8_LDA(At, 1, 1); PG8_STAGE(PG8_SB(1, 0), b3, voffB); PG8_STAGE(PG8_SB(1, 1), b3 + hstepB, voffB); PG8_STAGE(PG8_SA(1, 0), a3, voffA);
            PG8_WAIT_V(8); PG8_WAIT_L(0); PG8_BAR; PG8_MMA(1, 0, At, B0); PG8_MMA(1, 1, At, B1); PG8_BAR; PG8_SCHED;
        }
        if (wr == 0) PG8_BAR;
        E(acc, cur, wr, wc, fr, fq);
        if (!has_next) break;
#pragma unroll
        for (int a = 0; a < 2; ++a)
#pragma unroll
            for (int b = 0; b < 2; ++b)
#pragma unroll
                for (int m = 0; m < 4; ++m)
#pragma unroll
                    for (int n = 0; n < 2; ++n) acc[a][b][m][n] = (f32x4){0.f, 0.f, 0.f, 0.f};
        cur = nxt; cA = nA; cB = nB; ++ui;
        if (wr == 1) PG8_BAR;
    }
    PG8_WAIT_V(0);
    PG8_BAR;
#undef PG8_SA
#undef PG8_SB
#undef PG8_STAGE
#undef PG8_LDA
#undef PG8_LDB
#undef PG8_MMA
#undef PG8_WAIT_V
#undef PG8_WAIT_L
#undef PG8_BAR
#undef PG8_SCHED
}

struct SchedGrid {
    int G, c, nM, nN, nt; const char* A; const char* B; size_t tsA, tsB; int rep;
    __device__ __forceinline__ bool next(int i, Unit& u) const {
        long L = (long)i * G + c; if (L >= (long)nM * nN * rep) return false; L %= (long)nM * nN;
        int pm, pn; tile_of((int)L, nM, nN, pm, pn);
        u.pm = pm; u.pn = pn; u.tag = 0; u.nt = nt; u.A = A + (size_t)pm * tsA; u.B = B + (size_t)pn * tsB; return true;
    }
};
struct SchedP2 {
    int G, c; const char* H; const char* W; int rep;
    __device__ __forceinline__ bool next(int i, Unit& u) const {
        long L = (long)i * G + c; if (L >= 64 * 13 * rep) return false; L %= 64 * 13;
        int pm, pn; tile_of((int)L, 64, 13, pm, pn);
        const size_t ts = (size_t)256 * 1024 * 2;
        u.pm = pm; u.pn = pn; u.tag = pn; u.nt = 16;
        if (pn < 11) { u.A = H + (size_t)pm * ts; u.B = W + 2 * ts + (size_t)pn * ts; }
        else { u.A = W + (size_t)(pn - 11) * ts; u.B = H + (size_t)pm * ts; }
        return true;
    }
};
struct SchedDft {
    int G, c; const char* D; const char* Z; int rep;
    __device__ __forceinline__ bool next(int i, Unit& u) const {
        const long Ll = (long)i * G + c; if (Ll >= 256 * rep) return false; const int L = (int)(Ll % 256);
        u.tag = 0;
        if (L < 128) { const int b = L >> 4, rem = L & 15, pmq = rem >> 2, cs = (rem >> 1) & 1, pnq = rem & 1;
            u.A = D + (size_t)cs * (1024 * 1024 * 2) + (size_t)pmq * (256 * 1024 * 2);
            u.B = Z + ((size_t)pnq * 256 * 16384 + 8192 + b * 1024) * 2; u.nt = 16; u.pm = 32 + b * 4 + pmq; u.pn = cs * 2 + pnq; }
        else { const int L2 = L - 128, b = L2 >> 2, cs = (L2 >> 1) & 1, pnq = L2 & 1;
            u.A = D + (size_t)2 * (1024 * 1024 * 2) + (size_t)cs * (256 * 1024 * 2);
            u.B = Z + ((size_t)pnq * 256 * 16384 + b * 256) * 2; u.nt = 4; u.pm = b; u.pn = cs * 2 + pnq; }
        return true;
    }
};
struct SchedP4 {
    int G, c; const char* X; const char* W; int rep;
    __device__ __forceinline__ bool next(int i, Unit& u) const {
        long Lt = (long)(i >> 1) * G + c; if (Lt >= 256 * rep) return false; Lt %= 256;
        int pm, pn; tile_of((int)Lt, 64, 4, pm, pn); const int sub = i & 1;
        u.pm = pm; u.pn = pn; u.tag = sub; u.nt = sub ? 8 : 16;
        u.A = X + (size_t)pm * 256 * 1536 * 2 + (sub ? 2048 : 0); u.B = W + (size_t)pn * 256 * 1536 * 2 + (sub ? 2048 : 0); return true;
    }
};

struct EpiP2 {
    static constexpr bool PERM = false;
    bf16_t *Q, *Kb, *Vb, *Gt, *ZT; float *ock, *ocv; const float *gq, *gk, *ropeC, *ropeS;
    __device__ __forceinline__ void operator()(const f32x4 (&acc)[2][2][4][2], const Unit& u, int wr, int wc, int fr, int fq) const {
        const int pn = u.pn;
        if (pn >= 11) {
            const int ch0 = (pn - 11) * 256 + wr * 64 + fr, tok0 = u.pm * 256 + wc * 32 + 4 * fq;
#pragma unroll
            for (int ai = 0; ai < 2; ++ai)
#pragma unroll
                for (int m = 0; m < 4; ++m) { bf16_t* rowp = ZT + (size_t)(ch0 + ai * 128 + m * 16) * 16384 + tok0;
#pragma unroll
                    for (int bj = 0; bj < 2; ++bj)
#pragma unroll
                        for (int n = 0; n < 2; ++n) { const f32x4 v = acc[ai][bj][m][n]; u32x2 w; w.x = cvt_pk_bf16(v[0], v[1]); w.y = cvt_pk_bf16(v[2], v[3]); *(u32x2*)(rowp + bj * 128 + n * 16) = w; } }
        } else if (pn >= 3) {
            const int row0 = u.pm * 256 + wr * 64 + fr, col0 = (pn - 3) * 256 + wc * 32 + 4 * fq;
#pragma unroll
            for (int ai = 0; ai < 2; ++ai)
#pragma unroll
                for (int m = 0; m < 4; ++m) { bf16_t* rowp = Gt + (size_t)(row0 + ai * 128 + m * 16) * 2048 + col0;
#pragma unroll
                    for (int bj = 0; bj < 2; ++bj)
#pragma unroll
                        for (int n = 0; n < 2; ++n) { const f32x4 v = acc[ai][bj][m][n]; float s[4];
#pragma unroll
                            for (int j = 0; j < 4; ++j) s[j] = __builtin_amdgcn_rcpf(1.f + __expf(-v[j]));
                            u32x2 w; w.x = cvt_pk_bf16(s[0], s[1]); w.y = cvt_pk_bf16(s[2], s[3]); *(u32x2*)(rowp + bj * 128 + n * 16) = w; } }
        } else {
            const bool lat = u.pm >= 32, isv = (pn == 2 && wc >= 2);
            f32x4 g[2][2];
#pragma unroll
            for (int bj = 0; bj < 2; ++bj)
#pragma unroll
                for (int n = 0; n < 2; ++n) { const f32x4 ga = *(const f32x4*)(gq + 32 * bj + 16 * n + 4 * fq), gb = *(const f32x4*)(gk + 32 * bj + 16 * n + 4 * fq); g[bj][n] = pn < 2 ? ga : gb; }
#pragma unroll
            for (int ai = 0; ai < 2; ++ai)
#pragma unroll
                for (int m = 0; m < 4; ++m) {
                    const int r = u.pm * 256 + ai * 128 + wr * 64 + m * 16 + fr;
                    f32x4 v[2][2];
#pragma unroll
                    for (int bj = 0; bj < 2; ++bj)
#pragma unroll
                        for (int n = 0; n < 2; ++n) v[bj][n] = acc[ai][bj][m][n];
                    if (!isv) {
                        float ss = 0.f;
#pragma unroll
                        for (int bj = 0; bj < 2; ++bj)
#pragma unroll
                            for (int n = 0; n < 2; ++n) { const f32x4 x = v[bj][n]; ss += (x[0] * x[0] + x[1] * x[1]) + (x[2] * x[2] + x[3] * x[3]); }
                        ss += __shfl_xor(ss, 16); ss += __shfl_xor(ss, 32);
                        const float rstd = rsqrtf(ss * (1.f / 64.f) + 1e-6f);
#pragma unroll
                        for (int bj = 0; bj < 2; ++bj)
#pragma unroll
                            for (int n = 0; n < 2; ++n) v[bj][n] = v[bj][n] * rstd * g[bj][n];
                    }
                    if (pn == 2 && !lat) {
                        float* o = ock + (isv ? (size_t)NPROMPT * 128 : (size_t)0) + (size_t)r * 128 + (wc & 1) * 64 + 4 * fq;
#pragma unroll
                        for (int bj = 0; bj < 2; ++bj)
#pragma unroll
                            for (int n = 0; n < 2; ++n) *(f32x4*)(o + 32 * bj + 16 * n) = v[bj][n];
                    }
                    if (!isv && lat) {
                        const int s = (r - NPROMPT) & 1023;
#pragma unroll
                        for (int bj = 0; bj < 2; ++bj) { const int pos = bj ? (s & 63) : (s >> 6);
                            const f32x4 ct = *(const f32x4*)(ropeC + pos * 16 + 4 * fq), sn = *(const f32x4*)(ropeS + pos * 16 + 4 * fq);
                            const f32x4 x1 = v[bj][0], x2 = v[bj][1]; v[bj][0] = x1 * ct - x2 * sn; v[bj][1] = x1 * sn + x2 * ct; }
                    }
                    const size_t doff = (pn < 2) ? (size_t)r * 512 + (4 * pn + wc) * 64 : (isv ? (WS_V - WS_Q) / 2 : (WS_K - WS_Q) / 2) + (size_t)r * 128 + (wc & 1) * 64;
                    bf16_t* dst = Q + doff;
#pragma unroll
                    for (int bj = 0; bj < 2; ++bj)
#pragma unroll
                        for (int n = 0; n < 2; ++n) { const f32x4 x = v[bj][n]; u32x2 w; w.x = cvt_pk_bf16(x[0], x[1]); w.y = cvt_pk_bf16(x[2], x[3]); *(u32x2*)(dst + 32 * bj + 16 * n + 4 * fq) = w; }
                }
        }
    }
};
struct EpiStore {
    static constexpr bool PERM = true;
    bf16_t* O; int ldc;
    __device__ __forceinline__ void operator()(const f32x4 (&acc)[2][2][4][2], const Unit& u, int wr, int wc, int fr, int fq) const {
        const int row0 = u.pm * 256 + wr * 64 + fr, col0 = u.pn * 256 + wc * 32 + 8 * fq;
#pragma unroll
        for (int ai = 0; ai < 2; ++ai)
#pragma unroll
            for (int m = 0; m < 4; ++m) { bf16_t* rowp = O + (size_t)(row0 + ai * 128 + m * 16) * ldc + col0;
#pragma unroll
                for (int bj = 0; bj < 2; ++bj) { const f32x4 v0 = acc[ai][bj][m][0], v1 = acc[ai][bj][m][1];
                    u32x4 w; w.x = cvt_pk_bf16(v0[0], v0[1]); w.y = cvt_pk_bf16(v0[2], v0[3]); w.z = cvt_pk_bf16(v1[0], v1[1]); w.w = cvt_pk_bf16(v1[2], v1[3]);
                    *(u32x4*)(rowp + bj * 128) = w; } }
    }
};
struct EpiP4 {
    static constexpr bool PERM = true;
    bf16_t* T; const bf16_t* Gt;
    static constexpr long MRG_OFF = ((long)WS_H - (long)WS_T) / 2;
    __device__ __forceinline__ void operator()(const f32x4 (&acc)[2][2][4][2], const Unit& u, int wr, int wc, int fr, int fq) const {
        const int row0 = u.pm * 256 + wr * 64 + fr, col0 = u.pn * 256 + wc * 32 + 8 * fq; const int sub = u.tag;
#pragma unroll
        for (int ai = 0; ai < 2; ++ai)
#pragma unroll
            for (int m = 0; m < 4; ++m) { const size_t r = (size_t)(row0 + ai * 128 + m * 16);
#pragma unroll
                for (int bj = 0; bj < 2; ++bj) { const int c = col0 + bj * 128; const f32x4 v0 = acc[ai][bj][m][0], v1 = acc[ai][bj][m][1];
                    const u32x4 gw = *(const u32x4*)(Gt + r * 2048 + (sub ? 1024 : 0) + c);
                    float o[8] = { v0[0] * bf_lo(gw.x), v0[1] * bf_hi(gw.x), v0[2] * bf_lo(gw.y), v0[3] * bf_hi(gw.y), v1[0] * bf_lo(gw.z), v1[1] * bf_hi(gw.z), v1[2] * bf_lo(gw.w), v1[3] * bf_hi(gw.w) };
                    if (sub) { const u32x4 tw = *(const u32x4*)(T + r * 1024 + c);
                        o[0] += bf_lo(tw.x); o[1] += bf_hi(tw.x); o[2] += bf_lo(tw.y); o[3] += bf_hi(tw.y); o[4] += bf_lo(tw.z); o[5] += bf_hi(tw.z); o[6] += bf_lo(tw.w); o[7] += bf_hi(tw.w); }
                    u32x4 w; w.x = cvt_pk_bf16(o[0], o[1]); w.y = cvt_pk_bf16(o[2], o[3]); w.z = cvt_pk_bf16(o[4], o[5]); w.w = cvt_pk_bf16(o[6], o[7]);
                    *(u32x4*)(T + ((long)(sub ? MRG_OFF : 0L) + (long)(r * 1024 + c))) = w; } }
    }
};
struct EpiRes {
    static constexpr bool PERM = false;
    const float *bp, *bs; float* out; const float* gate;
    __device__ __forceinline__ void operator()(const f32x4 (&acc)[2][2][4][2], const Unit& u, int wr, int wc, int fr, int fq) const {
        const int v = u.pm < 32 ? 0 : 1 + ((u.pm - 32) >> 2);
        const int col0 = u.pn * 256 + wc * 32 + 4 * fq;
        f32x4 gt[2][2];
#pragma unroll
        for (int bj = 0; bj < 2; ++bj)
#pragma unroll
            for (int n = 0; n < 2; ++n) gt[bj][n] = *(const f32x4*)(gate + (size_t)v * 6144 + col0 + bj * 128 + n * 16);
#pragma unroll
        for (int ai = 0; ai < 2; ++ai)
#pragma unroll
            for (int m = 0; m < 4; ++m) { const int r = u.pm * 256 + ai * 128 + wr * 64 + m * 16 + fr;
                const float* b = (u.pm < 32 ? bp + (size_t)r * 1024 : bs + (size_t)(r - NPROMPT) * 1024) + col0; float* o = out + (size_t)r * 1024 + col0;
#pragma unroll
                for (int bj = 0; bj < 2; ++bj)
#pragma unroll
                    for (int n = 0; n < 2; ++n) { const f32x4 x = *(const f32x4*)(b + bj * 128 + n * 16); *(f32x4*)(o + bj * 128 + n * 16) = x + gt[bj][n] * acc[ai][bj][m][n]; } }
    }
};
struct EpiSwiglu {
    static constexpr bool PERM = true;
    bf16_t* O;
    __device__ __forceinline__ void operator()(const f32x4 (&acc)[2][2][4][2], const Unit& u, int wr, int wc, int fr, int fq) const {
        const int row0 = u.pm * 256 + wr * 64 + fr, col0 = u.pn * 128 + wc * 32 + 8 * fq;
#pragma unroll
        for (int ai = 0; ai < 2; ++ai)
#pragma unroll
            for (int m = 0; m < 4; ++m) { float o[8];
#pragma unroll
                for (int n = 0; n < 2; ++n)
#pragma unroll
                    for (int j = 0; j < 4; ++j) { const float a = acc[ai][0][m][n][j], uu = acc[ai][1][m][n][j]; o[4 * n + j] = a * __builtin_amdgcn_rcpf(1.f + __expf(-a)) * uu; }
                u32x4 w; w.x = cvt_pk_bf16(o[0], o[1]); w.y = cvt_pk_bf16(o[2], o[3]); w.z = cvt_pk_bf16(o[4], o[5]); w.w = cvt_pk_bf16(o[6], o[7]);
                *(u32x4*)(O + (size_t)(row0 + ai * 128 + m * 16) * DFF + col0) = w; }
    }
};
}

constexpr int AT_P = 72;
constexpr int AT_KS = 0, AT_VT = 64 * AT_P * 2, AT_PW = 2 * 64 * AT_P * 2, AT_WB = 64 * AT_P * 2;
__device__ __forceinline__ void attn_unit(LAS unsigned char* lds, int unit, const bf16_t* Q, const bf16_t* Kb, const bf16_t* Vb, const bf16_t* CK, const bf16_t* CV,
                                          bf16_t* O, const float* sinks, int tid, int wave, int lane) {
    const int fr = lane & 15, fq = lane >> 4;
    int qrow_base, kvh, nb = 0, krow_base, crow_base = 0; bool lat;
    if (unit < 128) { const int b = unit >> 2; kvh = (unit >> 1) & 1; qrow_base = b * 256 + (unit & 1) * 128; krow_base = b * 256; lat = false; }
    else { const int u2 = unit - 128, b = u2 >> 4; kvh = (u2 >> 3) & 1; nb = u2 & 7; qrow_base = NPROMPT + b * 1024 + nb * 128; krow_base = NPROMPT + b * 1024; crow_base = b * 256; lat = true; }
    const int g = wave >> 1, th = wave & 1, h = kvh * 4 + g;
    const int qrow0 = qrow_base + th * 64;
    bf16x8 qf[4][2];
#pragma unroll
    for (int qi = 0; qi < 4; ++qi)
#pragma unroll
        for (int s = 0; s < 2; ++s) { const bf16_t* Qu = Q + (size_t)qrow0 * 512 + h * 64; qf[qi][s] = *(const bf16x8*)(Qu + (unsigned)((qi * 16 + fr) * 512 + s * 32 + fq * 8)); }
    const float L2E = 1.4426950408889634f, sc = 0.125f * L2E;
    float m_[4], l_[4]; const float sk = sinks[h] * L2E;
#pragma unroll
    for (int qi = 0; qi < 4; ++qi) { m_[qi] = sk; l_[qi] = (fq == 0) ? 1.f : 0.f; }
    f32x4 o[4][4];
#pragma unroll
    for (int a = 0; a < 4; ++a)
#pragma unroll
        for (int b = 0; b < 4; ++b) o[a][b] = (f32x4){0.f, 0.f, 0.f, 0.f};
    LAS unsigned char* Pw = lds + AT_PW + wave * AT_WB;
    const int ntl = lat ? 6 : 0, ntot = ntl + 4;
#define AT_TILE(t, KS_, VS_, KT_, OK_) do { OK_ = true; KT_ = 0; if ((t) < ntl) { KT_ = 128 * (nb - 1) + 64 * (t); if (KT_ < 0 || KT_ >= 1024) OK_ = false; \
            const size_t ro_ = (size_t)(krow_base + (OK_ ? KT_ : 0)) * 128; KS_ = Kb + ro_; VS_ = Vb + ro_; } \
        else { const size_t ro_ = (size_t)((lat ? crow_base : krow_base) + ((t) - ntl) * 64) * 128; KS_ = (lat ? CK : Kb) + ro_; VS_ = (lat ? CV : Vb) + ro_; } } while (0)
    int tcur = 0; const bf16_t *ksrc, *vsrc; int ktok0; bool ok;
    for (;; ++tcur) { AT_TILE(tcur, ksrc, vsrc, ktok0, ok); if (ok) break; }
    const unsigned kofs = (unsigned)((tid >> 3) * 128 + kvh * 64 + (tid & 7) * 8), vofs = (unsigned)(lane * 128 + kvh * 64 + wave * 8);
    u32x4 kreg = *(const u32x4*)(ksrc + kofs);
    u32x4 vreg = *(const u32x4*)(vsrc + vofs);
    while (tcur < ntot) {
        const bool masked = (tcur < ntl) && (tcur < 2 || tcur >= 4); const int ktokc = ktok0;
        __syncthreads();
        { const int key = tid >> 3, ch = tid & 7;
          *(LAS u32x4*)(lds + AT_KS + (key * AT_P + ch * 8) * 2) = kreg;
          LAS unsigned short* vt = (LAS unsigned short*)(lds + AT_VT) + (wave * 8) * AT_P + lane;
          vt[0 * AT_P] = (unsigned short)(vreg.x & 0xffffu); vt[1 * AT_P] = (unsigned short)(vreg.x >> 16);
          vt[2 * AT_P] = (unsigned short)(vreg.y & 0xffffu); vt[3 * AT_P] = (unsigned short)(vreg.y >> 16);
          vt[4 * AT_P] = (unsigned short)(vreg.z & 0xffffu); vt[5 * AT_P] = (unsigned short)(vreg.z >> 16);
          vt[6 * AT_P] = (unsigned short)(vreg.w & 0xffffu); vt[7 * AT_P] = (unsigned short)(vreg.w >> 16); }
        int tn = tcur + 1;
        for (; tn < ntot; ++tn) { AT_TILE(tn, ksrc, vsrc, ktok0, ok); if (ok) break; }
        if (tn < ntot) { kreg = *(const u32x4*)(ksrc + kofs); vreg = *(const u32x4*)(vsrc + vofs); }
        __syncthreads();
#pragma unroll
        for (int qh = 0; qh < 2; ++qh) {
        f32x4 st[4][2];
#pragma unroll
        for (int kb = 0; kb < 4; ++kb) {
            const bf16x8 k0 = *(const LAS bf16x8*)(lds + AT_KS + ((kb * 16 + fr) * AT_P + fq * 8) * 2), k1 = *(const LAS bf16x8*)(lds + AT_KS + ((kb * 16 + fr) * AT_P + 32 + fq * 8) * 2);
#pragma unroll
            for (int q2 = 0; q2 < 2; ++q2) { f32x4 a = (f32x4){0.f, 0.f, 0.f, 0.f};
                a = __builtin_amdgcn_mfma_f32_16x16x32_bf16(k0, qf[2 * qh + q2][0], a, 0, 0, 0); a = __builtin_amdgcn_mfma_f32_16x16x32_bf16(k1, qf[2 * qh + q2][1], a, 0, 0, 0); st[kb][q2] = a; }
        }
#pragma unroll
        for (int q2 = 0; q2 < 2; ++q2) { const int qi = 2 * qh + q2;
            float mx = -INFINITY;
            if (masked) { const int qt = nb * 128 + th * 64 + qi * 16 + fr;
#pragma unroll
                for (int kb = 0; kb < 4; ++kb)
#pragma unroll
                    for (int j = 0; j < 4; ++j) { const int d = qt - (ktokc + kb * 16 + fq * 4 + j); if (d > 128 || d < -128) st[kb][q2][j] = -INFINITY; } }
#pragma unroll
            for (int kb = 0; kb < 4; ++kb) mx = fmaxf(fmaxf(mx, fmaxf(st[kb][q2][0], st[kb][q2][1])), fmaxf(st[kb][q2][2], st[kb][q2][3]));
            mx = fmaxf(mx, __shfl_xor(mx, 16)); mx = fmaxf(mx, __shfl_xor(mx, 32));
            const float mnew = fmaxf(m_[qi], mx * sc), alpha = __builtin_amdgcn_exp2f(m_[qi] - mnew); m_[qi] = mnew;
            float rs = 0.f;
#pragma unroll
            for (int kb = 0; kb < 4; ++kb) { f32x4 p;
#pragma unroll
                for (int j = 0; j < 4; ++j) { p[j] = __builtin_amdgcn_exp2f(__builtin_fmaf(st[kb][q2][j], sc, -mnew)); rs += p[j]; }
                u32x2 w; w.x = cvt_pk_bf16(p[0], p[1]); w.y = cvt_pk_bf16(p[2], p[3]);
                *(LAS u32x2*)(Pw + ((qi * 16 + fr) * AT_P + kb * 16 + fq * 4) * 2) = w; }
            l_[qi] = l_[qi] * alpha + rs;
#pragma unroll
            for (int db = 0; db < 4; ++db) o[db][qi] = o[db][qi] * alpha;
        }
        __builtin_amdgcn_sched_barrier(0);
        }
        asm volatile("s_waitcnt lgkmcnt(0)" ::: "memory");
#pragma unroll
        for (int s2 = 0; s2 < 2; ++s2) {
            bf16x8 pf[4];
#pragma unroll
            for (int qi = 0; qi < 4; ++qi) pf[qi] = *(const LAS bf16x8*)(Pw + ((qi * 16 + fr) * AT_P + s2 * 32 + fq * 8) * 2);
#pragma unroll
            for (int db = 0; db < 4; ++db) { const bf16x8 vf = *(const LAS bf16x8*)(lds + AT_VT + ((db * 16 + fr) * AT_P + s2 * 32 + fq * 8) * 2);
#pragma unroll
                for (int qi = 0; qi < 4; ++qi) o[db][qi] = __builtin_amdgcn_mfma_f32_16x16x32_bf16(vf, pf[qi], o[db][qi], 0, 0, 0); }
        }
        tcur = tn;
    }
#undef AT_TILE
    int fr2 = lane & 15, fq2 = lane >> 4; asm volatile("" : "+v"(fr2), "+v"(fq2));
#pragma unroll
    for (int qi = 0; qi < 4; ++qi) { float lt = l_[qi]; lt += __shfl_xor(lt, 16); lt += __shfl_xor(lt, 32); const float inv = 1.f / lt;
        bf16_t* Ou = O + (size_t)qrow0 * 1536 + h * 64; bf16_t* dst = Ou + (unsigned)((qi * 16 + fr2) * 1536 + fq2 * 4);
#pragma unroll
        for (int db = 0; db < 4; ++db) { const f32x4 v = o[db][qi] * inv; u32x2 w; w.x = cvt_pk_bf16(v[0], v[1]); w.y = cvt_pk_bf16(v[2], v[3]); *(u32x2*)(dst + db * 16) = w; } }
}

__device__ __forceinline__ float wave_sum(float v) {
#pragma unroll
    for (int o = 1; o < 64; o <<= 1) v += __shfl_xor(v, o);
    return v;
}
__device__ __forceinline__ int dest_row(int c, int mode) {
    if (mode == 1) { if (c < 512 || c >= 1280) return c; const int c2 = c - 512, pn = c2 >> 8, a = c2 & 255, wc = a >> 6, bj = (a >> 5) & 1; return 512 + 256 * pn + 128 * bj + 32 * wc + (a & 31); }
    if (mode == 2) { if (c < DFF) return 256 * (c >> 7) + (c & 127); const int j = c - DFF; return 256 * (j >> 7) + 128 + (j & 127); }
    return c;
}
__device__ __forceinline__ void p0_transpose_item(const float* W, int K, int N, bf16_t* WT, int ldw, int koff, int mode, LAS float* scr, int item, int lane) {
    const int nblk = N / 32, kb = item / nblk, nbk = item % nblk, k0 = 64 * kb, n0 = 32 * nbk;
    const unsigned lo_ = (unsigned)((lane >> 5) * N + (lane & 31));
#pragma unroll
    for (int h = 0; h < 2; ++h) { float t[16];
#pragma unroll
        for (int i = 0; i < 16; ++i) { const float* rowp = W + (size_t)(k0 + 2 * (16 * h + i)) * N + n0; t[i] = rowp[lo_]; }
#pragma unroll
        for (int i = 0; i < 16; ++i) scr[(2 * (16 * h + i) + (lane >> 5)) * 33 + (lane & 31)] = t[i]; }
    asm volatile("s_waitcnt lgkmcnt(0)" ::: "memory");
    const int c = lane & 7; const int d0 = dest_row(n0, mode);
#pragma unroll
    for (int j = 0; j < 4; ++j) { const int n = (lane >> 3) + 8 * j; const LAS float* s = scr + (8 * c) * 33 + n;
        u32x4 o; o.x = f2bf(s[0 * 33]) | (f2bf(s[1 * 33]) << 16); o.y = f2bf(s[2 * 33]) | (f2bf(s[3 * 33]) << 16); o.z = f2bf(s[4 * 33]) | (f2bf(s[5 * 33]) << 16); o.w = f2bf(s[6 * 33]) | (f2bf(s[7 * 33]) << 16);
        *(u32x4*)(WT + (size_t)(d0 + n) * ldw + koff + k0 + 8 * c) = o; }
    asm volatile("s_waitcnt lgkmcnt(0)" ::: "memory");
}
__device__ __forceinline__ void p0_fold_item(const float* wf, bf16_t* Wcat, LAS float* scr, int item, int lane) {
    const int g = item >> 8, o0 = (item & 255) * 4;
    LAS float* tw = scr;
    LAS float* tc = scr + 512;
    LAS float* ts = scr + 640;
#pragma unroll
    for (int i = 0; i < 2; ++i) { const int l = lane + 64 * i; const f32x4 v = *(const f32x4*)(wf + (size_t)(g * 128 + l) * 1024 + o0); *(LAS f32x4*)(tw + l * 4) = v;
        tc[l] = cospif((float)l * (1.f / 64.f)); ts[l] = sinpif((float)l * (1.f / 64.f)); }
    asm volatile("s_waitcnt lgkmcnt(0)" ::: "memory");
    float ce[4], co[4], se[4], so[4];
#pragma unroll
    for (int j = 0; j < 4; ++j) { ce[j] = 0.f; co[j] = 0.f; se[j] = 0.f; so[j] = 0.f; }
    const int c = lane;
#pragma unroll 4
    for (int l = 0; l < 128; l += 2) {
        { const int idx = (l * c) & 127; const float cv = tc[idx], sv = ts[idx]; const f32x4 w = *(const LAS f32x4*)(tw + l * 4);
#pragma unroll
          for (int j = 0; j < 4; ++j) { ce[j] += cv * w[j]; se[j] += sv * w[j]; } }
        { const int idx = ((l + 1) * c) & 127; const float cv = tc[idx], sv = ts[idx]; const f32x4 w = *(const LAS f32x4*)(tw + (l + 1) * 4);
#pragma unroll
          for (int j = 0; j < 4; ++j) { co[j] += cv * w[j]; so[j] += sv * w[j]; } }
    }
    const float sc = 0.08838834764831845f;
#pragma unroll
    for (int j = 0; j < 4; ++j) { bf16_t* row = Wcat + (size_t)(o0 + j) * 1536 + g * 128;
        row[c] = (bf16_t)f2bf((ce[j] + co[j]) * sc); row[c + 64] = (bf16_t)f2bf((ce[j] - co[j]) * sc);
        row[512 + c] = (bf16_t)f2bf(-(se[j] + so[j]) * sc); row[512 + c + 64] = (bf16_t)f2bf(-(se[j] - so[j]) * sc); }
    asm volatile("s_waitcnt lgkmcnt(0)" ::: "memory");
}
__device__ __forceinline__ void p0_ada_item(const float* w_ada, const float* c_lat, const float* c_ctx, float* part, LAS float* scr, int item, int lane) {
    const int cc = item % 96, ic = item / 96, j = cc * 64 + lane, i0 = ic * 128;
#pragma unroll
    for (int v = 0; v < 9; ++v)
#pragma unroll
        for (int hh = 0; hh < 2; ++hh) { const int i = lane + 64 * hh; const float x = (v == 0) ? c_ctx[i0 + i] : c_lat[(v - 1) * 1024 + i0 + i]; scr[v * 128 + i] = x / (1.f + __expf(-x)); }
    asm volatile("s_waitcnt lgkmcnt(0)" ::: "memory");
    float acc[9];
#pragma unroll
    for (int v = 0; v < 9; ++v) acc[v] = 0.f;
#pragma unroll 1
    for (int i = 0; i < 128; i += 16) { float w[16];
#pragma unroll
        for (int q = 0; q < 16; ++q) { const float* rowp = w_ada + (size_t)(i0 + i + q) * 6144 + cc * 64; w[q] = rowp[lane]; }
#pragma unroll
        for (int q = 0; q < 16; q += 4)
#pragma unroll
            for (int v = 0; v < 9; ++v) { const f32x4 sv = *(const LAS f32x4*)(scr + v * 128 + i + q); acc[v] += (sv[0] * w[q] + sv[1] * w[q + 1]) + (sv[2] * w[q + 2] + sv[3] * w[q + 3]); } }
#pragma unroll
    for (int v = 0; v < 9; ++v) part[((size_t)ic * 9 + v) * 6144 + j] = acc[v];
    asm volatile("s_waitcnt lgkmcnt(0)" ::: "memory");
}

__device__ __forceinline__ void norm_chunk(LAS unsigned char* lds, int chunk, const float* xp, const float* xs, const float* gnorm, const float* modsrc, const float* b_ada, bool partials,
                                           int off_shift, int off_scale, bf16_t* out, int tid, int wave, int lane) {
    const int row0 = chunk * 64; const int v = row0 < NPROMPT ? 0 : 1 + ((row0 - NPROMPT) >> 10);
    LAS float* la = (LAS float*)lds; LAS float* ls = la + 1024;
    __syncthreads();
    for (int col = tid; col < 1024; col += 512) {
        float sc, sh;
        if (partials) { sc = b_ada[off_scale + col]; sh = b_ada[off_shift + col];
#pragma unroll
            for (int p = 0; p < 8; ++p) { sc += modsrc[((size_t)p * 9 + v) * 6144 + off_scale + col]; sh += modsrc[((size_t)p * 9 + v) * 6144 + off_shift + col]; } }
        else { sc = modsrc[(size_t)v * 6144 + off_scale + col]; sh = modsrc[(size_t)v * 6144 + off_shift + col]; }
        la[col] = gnorm[col] * (1.f + sc); ls[col] = sh;
    }
    __syncthreads();
    for (int rr = 0; rr < 8; ++rr) {
        const int row = row0 + wave * 8 + rr;
        const float* xr = row < NPROMPT ? xp + (size_t)row * 1024 : xs + (size_t)(row - NPROMPT) * 1024;
        f32x4 x[4]; float ss = 0.f;
#pragma unroll
        for (int j = 0; j < 4; ++j) { x[j] = *(const f32x4*)(xr + 4 * lane + 256 * j); ss += (x[j][0] * x[j][0] + x[j][1] * x[j][1]) + (x[j][2] * x[j][2] + x[j][3] * x[j][3]); }
        const float rstd = rsqrtf(wave_sum(ss) * (1.f / 1024.f) + 1e-6f);
#pragma unroll
        for (int j = 0; j < 4; ++j) { const f32x4 a = *(const LAS f32x4*)(la + 4 * lane + 256 * j), s = *(const LAS f32x4*)(ls + 4 * lane + 256 * j);
            const f32x4 y = x[j] * rstd * a + s; u32x2 w; w.x = cvt_pk_bf16(y[0], y[1]); w.y = cvt_pk_bf16(y[2], y[3]);
            *(u32x2*)(out + (size_t)row * 1024 + 4 * lane + 256 * j) = w; }
    }
}

#define XB_TMO      128
#define XB_XCNT(j)  (256  + 64 * (j))
#define XB_XSUB(j)  (1280 + 64 * (j))
#define XB_XGEN(j)  (2304 + 64 * (j))
#define XB_TOP      3328
#define XB_TOPGEN   3392
#define XCD_BAR_WORDS 3456
#define XB_SPIN_CAP (1u << 18)

__device__ __forceinline__ unsigned xb_ld(unsigned* p)              { return __hip_atomic_load(p, __ATOMIC_RELAXED, __HIP_MEMORY_SCOPE_AGENT); }
__device__ __forceinline__ unsigned xb_add(unsigned* p, unsigned v) { return __hip_atomic_fetch_add(p, v, __ATOMIC_RELAXED, __HIP_MEMORY_SCOPE_AGENT); }
__device__ __forceinline__ unsigned xb_xcc_id() { return (unsigned)__builtin_amdgcn_s_getreg((3 << 11) | 20) & 0xFu; }
#define XB_SPIN(cond, bar) do { unsigned _sp = 0; while (cond) { __builtin_amdgcn_s_sleep(1); \
    if ((++_sp & 255u) == 0u) { if (xb_ld(&(bar)[XB_TMO])) break; if (_sp > XB_SPIN_CAP) { atomicAdd(&(bar)[XB_TMO], 1u); break; } } } } while (0)

struct XcdBarrier {
    unsigned* bar; unsigned x;
    volatile LAS unsigned* st;
};

__device__ __forceinline__ XcdBarrier xcd_barrier_post(unsigned* bar, volatile LAS unsigned* st) {
    XcdBarrier b; b.bar = bar; b.x = xb_xcc_id(); b.st = st;
    if (threadIdx.x == 0) (void)xb_add(&bar[XB_XCNT(b.x)], 1u);
    return b;
}
__device__ __forceinline__ void xcd_barrier_complete(unsigned* bar, unsigned x, unsigned& nloc, unsigned& nx) {
    const unsigned G = gridDim.x * gridDim.y * gridDim.z;
    unsigned sum, cnt, mine, sp = 0u;
    for (;;) {
        sum = 0u; cnt = 0u; mine = 0u;
#pragma unroll
        for (unsigned j = 0; j < 16; ++j) { const unsigned c = xb_ld(&bar[XB_XCNT(j)]); sum += c; cnt += (c > 0u) ? 1u : 0u; mine = (j == x) ? c : mine; }
        if (sum == G) break;
        __builtin_amdgcn_s_sleep(1);
        if ((++sp & 255u) == 0u) { if (xb_ld(&bar[XB_TMO])) break; if (sp > XB_SPIN_CAP) { atomicAdd(&bar[XB_TMO], 1u); break; } }
    }
    nloc = mine > 0u ? mine : 1u; nx = cnt > 0u ? cnt : 1u;
}

__device__ __forceinline__ void xcd_barrier(const XcdBarrier& b) {
    asm volatile("s_waitcnt vmcnt(0)" ::: "memory");
    __syncthreads();
    if (threadIdx.x == 0) {
        unsigned* bar = b.bar;
        __builtin_amdgcn_s_waitcnt(0);
        unsigned nloc = b.st[0], nx = b.st[1];
        if (nloc == 0u) { xcd_barrier_complete(bar, b.x, nloc, nx); b.st[0] = nloc; b.st[1] = nx; }
        const unsigned old = xb_add(&bar[XB_XSUB(b.x)], 1u);
        const unsigned gen = old / nloc;
        if (old + 1u == (gen + 1u) * nloc) {
            __builtin_amdgcn_fence(__ATOMIC_RELEASE, "agent");
            asm volatile("s_waitcnt vmcnt(0)" ::: "memory");
            const unsigned og = xb_add(&bar[XB_TOP], 1u);
            const unsigned tg = og / nx;
            if (og + 1u == (tg + 1u) * nx) xb_add(&bar[XB_TOPGEN], 1u);
            else XB_SPIN(xb_ld(&bar[XB_TOPGEN]) == tg, bar);
            __builtin_amdgcn_fence(__ATOMIC_ACQUIRE, "agent");
            xb_add(&bar[XB_XGEN(b.x)], 1u);
            asm volatile("s_waitcnt vmcnt(0)" ::: "memory");
        } else {
            XB_SPIN(xb_ld(&bar[XB_XGEN(b.x)]) == gen, bar);
            __builtin_amdgcn_fence(__ATOMIC_ACQUIRE, "agent");
            asm volatile("s_waitcnt vmcnt(0)" ::: "memory");
        }
    }
    __syncthreads();
}

#define XL_SUB(j) (3456 + 64 * (j))
#define XL_GEN(j) (3456 + 1024 + 64 * (j))
__device__ __forceinline__ void xcd_local_barrier(const XcdBarrier& b) {
    asm volatile("s_waitcnt vmcnt(0)" ::: "memory");
    __syncthreads();
    if (threadIdx.x == 0) {
        unsigned* bar = b.bar; const unsigned nloc = b.st[0];
        const unsigned old = xb_add(&bar[XL_SUB(b.x)], 1u), gen = old / nloc;
        if (old + 1u == (gen + 1u) * nloc) xb_add(&bar[XL_GEN(b.x)], 1u);
        else XB_SPIN(xb_ld(&bar[XL_GEN(b.x)]) == gen, bar);
        __builtin_amdgcn_fence(__ATOMIC_ACQUIRE, "agent");
        asm volatile("s_waitcnt vmcnt(0)" ::: "memory");
    }
    __syncthreads();
}

struct Args { const float* in[19]; float* out; unsigned char* ws; int ph_lo, ph_hi; };
#ifndef MK_LAST
#define MK_LAST 9
#endif
constexpr int NPH = MK_LAST;

__global__ void __launch_bounds__(512, 2) mk_fwd(Args args) {
    extern __shared__ __attribute__((aligned(16))) unsigned char lds_raw[];
    LAS unsigned char* lds = (LAS unsigned char*)lds_raw;
    const int tid = threadIdx.x, lane = tid & 63, wave = __builtin_amdgcn_readfirstlane(tid >> 6);
    const int G = gridDim.x;
    unsigned char* ws = args.ws;
    const float* x_prompt = args.in[0]; const float* x_sample = args.in[1]; const float* cache_k = args.in[2]; const float* cache_v = args.in[3];
    const float* c_lat = args.in[4]; const float* c_ctx = args.in[5]; const float* w_ada = args.in[6]; const float* b_ada = args.in[7];
    const float* g_norm1 = args.in[8]; const float* g_norm2 = args.in[9]; const float* w_in = args.in[10]; const float* g_q = args.in[11]; const float* g_k = args.in[12];
    const float* sinks = args.in[13]; const float* w_f = args.in[14]; const float* w_ao = args.in[15]; const float* w_out = args.in[16]; const float* w_up = args.in[17]; const float* w_down = args.in[18];
    float* out = args.out;
    float* modp = (float*)(ws + WS_MODP); float* mod = (float*)(ws + WS_MOD); float* ropeC = (float*)(ws + WS_ROPE); float* ropeS = ropeC + 1024;
    bf16_t* Win = (bf16_t*)(ws + WS_WIN); bf16_t* Wcat = (bf16_t*)(ws + WS_WCAT); bf16_t* Wout = (bf16_t*)(ws + WS_WOUT); bf16_t* Wup = (bf16_t*)(ws + WS_WUP); bf16_t* Wdn = (bf16_t*)(ws + WS_WDN);
    bf16_t* Dft = (bf16_t*)(ws + WS_DFT); bf16_t* CK = (bf16_t*)(ws + WS_CK); bf16_t* CV = (bf16_t*)(ws + WS_CV);
    bf16_t* Hb = (bf16_t*)(ws + WS_H); bf16_t* ZT = (bf16_t*)(ws + WS_ZFT); bf16_t* Qb = (bf16_t*)(ws + WS_Q); bf16_t* Kb = (bf16_t*)(ws + WS_K); bf16_t* Vb = (bf16_t*)(ws + WS_V);
    bf16_t* Gt = (bf16_t*)(ws + WS_G); bf16_t* ABX = (bf16_t*)(ws + WS_ABX); bf16_t* Tb = (bf16_t*)(ws + WS_T); bf16_t* ACT = (bf16_t*)(ws + WS_ACT);
    float* out_ck = out + (size_t)MTOK * DM; float* out_cv = out_ck + (size_t)NPROMPT * 128;
    cg::grid_group grid = cg::this_grid();
    const int lo = args.ph_lo, hi = args.ph_hi;
#ifndef MK_REPEAT_MASK
#define MK_REPEAT_MASK 0
#endif
#if (MK_REPEAT_MASK >> 0) & 1
#define PH0 for (int rep_ = 0; rep_ < 2; ++rep_) if (IN(0))
#else
#define PH0 if (IN(0))
#endif
#if (MK_REPEAT_MASK >> 1) & 1
#define PH1 for (int rep_ = 0; rep_ < 2; ++rep_) if (IN(1))
#else
#define PH1 if (IN(1))
#endif
#if (MK_REPEAT_MASK >> 2) & 1
#define PH2 for (int rep_ = 0; rep_ < 2; ++rep_) if (IN(2))
#else
#define PH2 if (IN(2))
#endif
#if (MK_REPEAT_MASK >> 3) & 1
#define PH3 for (int rep_ = 0; rep_ < 2; ++rep_) if (IN(3))
#else
#define PH3 if (IN(3))
#endif
#if (MK_REPEAT_MASK >> 4) & 1
#define PH4 for (int rep_ = 0; rep_ < 2; ++rep_) if (IN(4))
#else
#define PH4 if (IN(4))
#endif
#if (MK_REPEAT_MASK >> 5) & 1
#define PH5 for (int rep_ = 0; rep_ < 2; ++rep_) if (IN(5))
#else
#define PH5 if (IN(5))
#endif
#if (MK_REPEAT_MASK >> 6) & 1
#define PH6 for (int rep_ = 0; rep_ < 2; ++rep_) if (IN(6))
#else
#define PH6 if (IN(6))
#endif
#if (MK_REPEAT_MASK >> 7) & 1
#define PH7 for (int rep_ = 0; rep_ < 2; ++rep_) if (IN(7))
#else
#define PH7 if (IN(7))
#endif
#define NREP(k) ((((MK_REPEAT_MASK) >> (k)) & 1) ? 2 : 1)
#define IN(k) (lo <= (k) && (k) < hi)
#define SEAM(k) do { if (IN(k) && IN((k) + 1)) xcd_barrier(bar); } while (0)
#define SEAM_L(k) do { if (IN(k) && IN((k) + 1)) { if (uni) xcd_local_barrier(bar); else xcd_barrier(bar); } } while (0)
    volatile LAS unsigned* bst = (volatile LAS unsigned*)(lds + 131072 + 1024);
    XcdBarrier bar; bar.bar = (unsigned*)ws; bar.x = xb_xcc_id(); bar.st = bst;
    if (tid == 0) {
        const unsigned rk = xb_add(&bar.bar[XB_XCNT(bar.x)], 1u);
        unsigned nloc, nx; xcd_barrier_complete(bar.bar, bar.x, nloc, nx);
        bool uni = (G == 256) && (bar.x < 8u);
        for (unsigned j = 0; j < 8; ++j) uni = uni && (xb_ld(&bar.bar[XB_XCNT(j)]) == 32u);
        bst[0] = nloc; bst[1] = nx; bst[2] = uni ? (rk * 8u + bar.x) : (unsigned)blockIdx.x; bst[3] = uni ? 1u : 0u; bst[4] = uni ? (bar.x * 32u + rk) : (unsigned)blockIdx.x;
    }
    __syncthreads();
    const int c = (int)bst[2];
    const bool uni = bst[3] != 0u;
    const int crow = (int)bst[4];
    if (lo < 0) grid.sync();

    if (NREP(10) == 2) { for (int i_ = 0; i_ < 8; ++i_) xcd_barrier(bar); }
    PH0 {
        LAS float* scr = (LAS float*)(lds + wave * 16384);
        const int gw = c * 8 + wave, NGW = G * 8;
        constexpr int I_ADA = 768, I_IN = 16 * (INW / 32);
        for (int it = gw; it < I_ADA + I_IN; it += NGW) {
            if (it < I_ADA) { p0_ada_item(w_ada, c_lat, c_ctx, modp, scr, it, lane); continue; }
            p0_transpose_item(w_in, 1024, INW, Win, 1024, 0, 1, scr, it - I_ADA, lane);
        }
        const int gt = c * 512 + tid, NGT = G * 512;
        for (int e = gt; e < 1024 * 1024; e += NGT) { const int k = e >> 10, n = e & 1023, idx = (k * n) & 1023; const float a = (float)idx * (1.f / 512.f);
            Dft[e] = (bf16_t)f2bf(cospif(a) * (1.f / 32.f)); Dft[1024 * 1024 + e] = (bf16_t)f2bf(sinpif(a) * (1.f / 32.f)); }
        for (int e = gt; e < 256 * 256; e += NGT) { const int k = e >> 8, n = e & 255, idx = (k * n) & 255; const float a = (float)idx * (1.f / 128.f);
            Dft[2 * 1024 * 1024 + k * 1024 + n] = (bf16_t)f2bf(cospif(a) * (1.f / 16.f)); Dft[2 * 1024 * 1024 + 256 * 1024 + k * 1024 + n] = (bf16_t)f2bf(sinpif(a) * (1.f / 16.f)); }
        for (int e = gt; e < 2048 * 128 / 4; e += NGT) { const f32x4 kx = *(const f32x4*)(cache_k + 4 * (size_t)e), vx = *(const f32x4*)(cache_v + 4 * (size_t)e);
            u32x2 w; w.x = cvt_pk_bf16(kx[0], kx[1]); w.y = cvt_pk_bf16(kx[2], kx[3]); *(u32x2*)(CK + 4 * (size_t)e) = w;
            w.x = cvt_pk_bf16(vx[0], vx[1]); w.y = cvt_pk_bf16(vx[2], vx[3]); *(u32x2*)(CV + 4 * (size_t)e) = w; }
        for (int e = gt; e < 1024; e += NGT) { const int pos = e >> 4, i = e & 15; const float inv = powf(10000.f, -(float)i * (1.f / 16.f)); const float ang = (float)pos * inv;
            ropeC[e] = cosf(ang); ropeS[e] = sinf(ang); }
    }
    SEAM(0);
    if (IN(1)) {
        for (int e = c * 512 + tid; e < 9 * 6144; e += G * 512) { const int v = e / 6144, j = e % 6144; float s = b_ada[j];
#pragma unroll
            for (int p = 0; p < 8; ++p) s += modp[((size_t)p * 9 + v) * 6144 + j];
            mod[e] = s; }
        for (int ch = crow; ch < 256 * NREP(1); ch += G) norm_chunk(lds, ch & 255, x_prompt, x_sample, g_norm1, modp, b_ada, true, 0, 1024, Hb, tid, wave, lane);
        __syncthreads();
    }
    SEAM_L(1);
    if (IN(2)) {
        pg8::SchedP2 S{G, c, (const char*)Hb, (const char*)Win, NREP(2)};
        pg8::EpiP2 E{Qb, Kb, Vb, Gt, ZT, out_ck, out_cv, g_q, g_k, ropeC, ropeS};
        pg8::gemm_phase<pg8::EpiP2, pg8::SchedP2>(lds, 1024, 1024, S, E);
        {
            const int nshort = (G == 256) ? 192 : G, sidx = (G == 256) ? c - 64 : c;
            if (sidx >= 0) {
                LAS float* scr = (LAS float*)(lds + wave * 16384);
                constexpr int I_FOLD = 1024, I_AO = 8 * 32, I_OUT = 16 * 32, I_UP = 16 * (2 * DFF / 32), I_DN = (DFF / 64) * 32;
                constexpr int NIT2 = I_FOLD + I_AO + I_OUT + I_UP + I_DN;
                for (int it = sidx * 8 + wave; it < NIT2; it += nshort * 8) {
                    int r = it;
                    if (r < I_FOLD) { p0_fold_item(w_f, Wcat, scr, r, lane); continue; } r -= I_FOLD;
                    const float* W; int K, N, ldw, koff, mode; bf16_t* WT;
                    if (r < I_AO) { W = w_ao; K = 512; N = 1024; WT = Wcat; ldw = 1536; koff = 1024; mode = 0; }
                    else if ((r -= I_AO) < I_OUT) { W = w_out; K = 1024; N = 1024; WT = Wout; ldw = 1024; koff = 0; mode = 0; }
                    else if ((r -= I_OUT) < I_UP) { W = w_up; K = 1024; N = 2 * DFF; WT = Wup; ldw = 1024; koff = 0; mode = 2; }
                    else { r -= I_UP; W = w_down; K = DFF; N = 1024; WT = Wdn; ldw = DFF; koff = 0; mode = 0; }
                    p0_transpose_item(W, K, N, WT, ldw, koff, mode, scr, r, lane);
                }
            }
        }
    }
    SEAM(2);
    if (IN(3)) {
        pg8::SchedDft S{G, c, (const char*)Dft, (const char*)ZT, NREP(3)};
        pg8::EpiStore E{ABX, 1536};
        pg8::gemm_phase<pg8::EpiStore, pg8::SchedDft>(lds, 1024, 16384, S, E);
        if (c < 256) attn_unit(lds, c, Qb, Kb, Vb, CK, CV, ABX + 1024, sinks, tid, wave, lane);
        __syncthreads();
    }
    SEAM(3);
#ifdef MK_DBG
    if (IN(4)) {
        for (size_t e = (size_t)c * 512 + tid; e < (size_t)MTOK * 1024; e += (size_t)G * 512) { const size_t r = e >> 10; const int cc = (int)(e & 1023);
            float v = 0.f;
            if (MK_DBG == 1) v = bf_lo(ABX[r * 1536 + cc]);
            else if (MK_DBG == 2) v = cc < 512 ? bf_lo(ABX[r * 1536 + 1024 + cc]) : 0.f;
            else if (MK_DBG == 4) v = (cc < 512 && r < 8192) ? bf_lo(ABX[r * 1536 + 1024 + cc]) : 0.f;
            else if (MK_DBG == 3) v = cc < 512 ? bf_lo(Qb[r * 512 + cc]) : (cc < 640 ? bf_lo(Kb[r * 128 + cc - 512]) : (cc < 768 ? bf_lo(Vb[r * 128 + cc - 640]) : (r < 2048 ? (cc < 896 ? bf_lo(CK[r * 128 + cc - 768]) : bf_lo(CV[r * 128 + cc - 896])) : 0.f)));
            out[e] = v; }
    }
#else
    if (IN(4)) {
        pg8::SchedP4 S{G, c, (const char*)ABX, (const char*)Wcat, NREP(4)};
        pg8::EpiP4 E{Tb, Gt};
        pg8::gemm_phase<pg8::EpiP4, pg8::SchedP4>(lds, 1536, 1536, S, E);
    }
#endif
    SEAM_L(4);
    if (IN(5)) {
        pg8::SchedGrid S{G, c, 64, 4, 16, (const char*)Hb, (const char*)Wout, (size_t)256 * 1024 * 2, (size_t)256 * 1024 * 2, NREP(5)};
        pg8::EpiRes E{x_prompt, x_sample, out, mod + 2048};
        pg8::gemm_phase<pg8::EpiRes, pg8::SchedGrid>(lds, 1024, 1024, S, E);
    }
    SEAM_L(5);
    if (IN(6)) {
        for (int ch = crow; ch < 256 * NREP(6); ch += G) norm_chunk(lds, ch & 255, out, out + (size_t)NPROMPT * 1024, g_norm2, mod, b_ada, false, 3072, 4096, Hb, tid, wave, lane);
        __syncthreads();
    }
    SEAM_L(6);
    if (IN(7)) {
        pg8::SchedGrid S{G, c, 64, 22, 16, (const char*)Hb, (const char*)Wup, (size_t)256 * 1024 * 2, (size_t)256 * 1024 * 2, NREP(7)};
        pg8::EpiSwiglu E{ACT};
        pg8::gemm_phase<pg8::EpiSwiglu, pg8::SchedGrid>(lds, 1024, 1024, S, E);
    }
    SEAM_L(7);
    if (IN(8)) {
        pg8::SchedGrid S{G, c, 64, 4, DFF / 64, (const char*)ACT, (const char*)Wdn, (size_t)256 * DFF * 2, (size_t)256 * DFF * 2, 1};
        pg8::EpiRes E{out, out + (size_t)NPROMPT * 1024, out, mod + 5120};
#if (MK_REPEAT_MASK >> 8) & 1
        { pg8::EpiRes E2{out, out + (size_t)NPROMPT * 1024, (float*)(ws + WS_ABX), mod + 5120}; pg8::gemm_phase<pg8::EpiRes, pg8::SchedGrid>(lds, DFF, DFF, S, E2); }
#endif
        pg8::gemm_phase<pg8::EpiRes, pg8::SchedGrid>(lds, DFF, DFF, S, E);
    }
#undef IN
#undef SEAM
}

extern "C" void kernel_launch(void* const* d_in, const int* in_sizes, int n_in, void* d_out, int out_size, void* d_ws, size_t ws_size, hipStream_t stream) {
    static int grid = 0;
    if (grid == 0) {
        int dev = 0, cus = 0, per_cu = 0;
        if (n_in != 19 || ws_size < 256 * MiB) { fprintf(stderr, "kernel_launch: unexpected n_in %d / ws_size %zu\n", n_in, ws_size); grid = -1; return; }
        (void)hipGetDevice(&dev);
        (void)hipDeviceGetAttribute(&cus, hipDeviceAttributeMultiprocessorCount, dev);
        if (hipFuncSetAttribute((const void*)mk_fwd, hipFuncAttributeMaxDynamicSharedMemorySize, LDS_BYTES) != hipSuccess) { fprintf(stderr, "kernel_launch: hipFuncSetAttribute failed\n"); grid = -1; return; }
        if (hipOccupancyMaxActiveBlocksPerMultiprocessor(&per_cu, (const void*)mk_fwd, 512, LDS_BYTES) != hipSuccess || per_cu < 1) { fprintf(stderr, "kernel_launch: occupancy query gives %d\n", per_cu); per_cu = 1; (void)hipGetLastError(); }
        grid = cus * 1;
        if (grid > 256) grid = 256;
        if (grid != 256) { fprintf(stderr, "kernel_launch: this kernel needs 256 CUs (got %d)\n", grid); grid = -1; return; }
    }
    if (grid < 0) return;
    if (hipMemsetAsync(d_ws, 0, 32768, stream) != hipSuccess) { fprintf(stderr, "kernel_launch: memset failed\n"); return; }
    Args a{};
    for (int i = 0; i < 19; ++i) a.in[i] = (const float*)d_in[i];
    a.out = (float*)d_out; a.ws = (unsigned char*)d_ws;
    for (int li = 0; li < (MK_N_LAUNCHES == 1 ? 1 : NPH); ++li) {
        a.ph_lo = (MK_N_LAUNCHES == 1) ? 0 : li; a.ph_hi = (MK_N_LAUNCHES == 1) ? NPH : li + 1;
        void* kargs[] = {&a};
        hipError_t e = hipLaunchCooperativeKernel((const void*)mk_fwd, dim3(grid), dim3(512), kargs, LDS_BYTES, stream);
        if (e != hipSuccess) { fprintf(stderr, "kernel_launch: cooperative launch failed: %s (grid %d)\n", hipGetErrorString(e), grid); break; }
    }
}
```

```cpp
#include <hip/hip_runtime.h>
#include <hip/hip_cooperative_groups.h>
#include <cstdio>
#include <cstdint>
namespace cg = cooperative_groups;

#ifndef MK_N_LAUNCHES
#define MK_N_LAUNCHES 1
#endif

#define LAS __attribute__((address_space(3)))
typedef unsigned short bf16_t;
typedef short bf16x8 __attribute__((ext_vector_type(8)));
typedef float f32x4 __attribute__((ext_vector_type(4)));
typedef unsigned u32x4 __attribute__((ext_vector_type(4)));
typedef unsigned u32x2 __attribute__((ext_vector_type(2)));

typedef float f32x2_t __attribute__((ext_vector_type(2))); typedef __bf16 bf16x2_t __attribute__((ext_vector_type(2)));
__device__ __forceinline__ unsigned cvt_pk_bf16(float lo, float hi) { f32x2_t v = {lo, hi}; bf16x2_t b = __builtin_convertvector(v, bf16x2_t); return __builtin_bit_cast(unsigned, b); }
__device__ __forceinline__ float bf_lo(unsigned w) { return __uint_as_float(w << 16); }
__device__ __forceinline__ float bf_hi(unsigned w) { return __uint_as_float(w & 0xffff0000u); }
__device__ __forceinline__ unsigned f2bf(float f) { unsigned u = __float_as_uint(f); return (u + 0x7fffu + ((u >> 16) & 1u)) >> 16; }

constexpr int DM = 1024, MTOK = 16384, NPROMPT = 8192;
constexpr int INW = 3328, DFF = 2816;
constexpr size_t MiB = 1u << 20;
constexpr size_t WS_MODP = 1 * MiB;
constexpr size_t WS_MOD = 3 * MiB;
constexpr size_t WS_ROPE = 3 * MiB + 512 * 1024;
constexpr size_t WS_WIN = 4 * MiB;
constexpr size_t WS_WCAT = 11 * MiB;
constexpr size_t WS_WOUT = 14 * MiB;
constexpr size_t WS_WUP = 16 * MiB;
constexpr size_t WS_WDN = 27 * MiB;
constexpr size_t WS_DFT = 33 * MiB;
constexpr size_t WS_CK = 38 * MiB, WS_CV = 38 * MiB + 512 * 1024;
constexpr size_t WS_H = 40 * MiB;
constexpr size_t WS_ZFT = 72 * MiB;
constexpr size_t WS_Q = 88 * MiB;
constexpr size_t WS_K = 104 * MiB, WS_V = 108 * MiB;
constexpr size_t WS_G = 112 * MiB;
constexpr size_t WS_ABX = 176 * MiB;
constexpr size_t WS_T = 224 * MiB;
constexpr size_t WS_ACT = 72 * MiB;
constexpr int LDS_BYTES = 147456;

namespace pg8 {
constexpr int BM = 256, BK = 64, HALF = 128, HTB = HALF * BK * 2, STAGE_BYTES = 8 * HTB, NXCD = 8, WGM = 8;
__host__ __device__ __forceinline__ int lds_byte(int r, int c) { const int st = (r >> 4) * 2 + (c >> 5), rr = r & 15, cc = c & 31, ob = rr * 64 + cc * 2; return st * 1024 + (ob ^ (((ob >> 9) & 1) << 5)); }
__host__ __device__ __forceinline__ void stage_rc(int b, int& R, int& C) { const int st = b / 1024, sb = b % 1024, swz = sb ^ (((sb >> 9) & 1) << 5); R = (st >> 1) * 16 + swz / 64; C = (st & 1) * 32 + (swz % 64) / 2; }
__host__ __device__ __forceinline__ int perm32(int rho) { const int n = rho >> 4, i = rho & 15; return 8 * (i >> 2) + 4 * n + (i & 3); }

struct Unit { const char* A; const char* B; int nt, pm, pn, tag; };

__device__ __forceinline__ void tile_of(int L, int nM, int nN, int& pm, int& pn) {
    const int nwg = nM * nN; int wgid = L;
    { const int q = nwg / NXCD, r = nwg % NXCD, xcd = wgid % NXCD, off = wgid / NXCD; wgid = (xcd < r ? xcd * (q + 1) : r * (q + 1) + (xcd - r) * q) + off; }
    const int nig = WGM * nN, gid = wgid / nig, fm = gid * WGM, gsz = (nM - fm) < WGM ? (nM - fm) : WGM;
    pm = fm + ((wgid % nig) % gsz); pn = (wgid % nig) / gsz;
}

template <class Epi, class Sched>
__device__ __forceinline__ void gemm_phase(LAS unsigned char* lds, const int lda, const int ldb, const Sched& S, const Epi& E) {
    const int tid = threadIdx.x, wid = __builtin_amdgcn_readfirstlane(tid >> 6), lane = tid & 63, wr = wid >> 2, wc = wid & 3, fr = lane & 15, fq = lane >> 4;
    unsigned voffA[2], voffB[2];
#pragma unroll
    for (int i = 0; i < 2; ++i) { int R, C; stage_rc(tid * 16 + i * 8192, R, C); const int Rb = Epi::PERM ? ((R & ~31) + perm32(R & 31)) : R;
        voffA[i] = (unsigned)(R * lda + C) * 2u; voffB[i] = (unsigned)(Rb * ldb + C) * 2u; }
    const size_t kstep = (size_t)(BK * 2);
    const size_t hstepA = (size_t)HALF * lda * 2, hstepB = (size_t)HALF * ldb * 2;
    const unsigned ldsw = (unsigned)wid * 1024u;
    const int aoff = lds_byte(wr * 64 + fr, fq * 8), boff = lds_byte(wc * 32 + fr, fq * 8);
#define PG8_SA(b, h) (((b) * 2 + (h)) * HTB)
#define PG8_SB(b, h) ((4 + (b) * 2 + (h)) * HTB)
#define PG8_STAGE(bufoff, gbase, voff) do { _Pragma("unroll") for (int _i = 0; _i < 2; ++_i) \
        __builtin_amdgcn_global_load_lds((const unsigned*)((const char*)(gbase) + (voff)[_i]), (LAS unsigned*)(lds + (bufoff) + ldsw + _i * 8192), 16, 0, 0); } while (0)
#define PG8_LDA(dst, b, h) do { _Pragma("unroll") for (int m = 0; m < 4; ++m) _Pragma("unroll") for (int k = 0; k < 2; ++k) dst[m][k] = *(const LAS bf16x8*)(lds + PG8_SA(b, h) + aoff + m * 2048 + k * 1024); } while (0)
#define PG8_LDB(dst, b, h) do { _Pragma("unroll") for (int n = 0; n < 2; ++n) _Pragma("unroll") for (int k = 0; k < 2; ++k) dst[n][k] = *(const LAS bf16x8*)(lds + PG8_SB(b, h) + boff + n * 2048 + k * 1024); } while (0)
#define PG8_MMA(ai, bj, At, Bt) do { __builtin_amdgcn_s_setprio(1); _Pragma("unroll") for (int m = 0; m < 4; ++m) _Pragma("unroll") for (int n = 0; n < 2; ++n) _Pragma("unroll") for (int k = 0; k < 2; ++k) \
        acc[ai][bj][m][n] = __builtin_amdgcn_mfma_f32_16x16x32_bf16(Bt[n][k], At[m][k], acc[ai][bj][m][n], 0, 0, 0); __builtin_amdgcn_s_setprio(0); } while (0)
#define PG8_WAIT_V(n) asm volatile("s_waitcnt vmcnt(" #n ")" ::: "memory")
#define PG8_WAIT_L(n) asm volatile("s_waitcnt lgkmcnt(" #n ")" ::: "memory")
#define PG8_BAR __builtin_amdgcn_s_barrier()
#define PG8_SCHED __builtin_amdgcn_sched_barrier(0)
    Unit cur, nxt; int ui = 0;
    if (!S.next(0, cur)) return;
    f32x4 acc[2][2][4][2];
#pragma unroll
    for (int a = 0; a < 2; ++a)
#pragma unroll
        for (int b = 0; b < 2; ++b)
#pragma unroll
            for (int m = 0; m < 4; ++m)
#pragma unroll
                for (int n = 0; n < 2; ++n) acc[a][b][m][n] = (f32x4){0.f, 0.f, 0.f, 0.f};
    bf16x8 At[4][2], B0[2][2], B1[2][2];
    const char* cA = cur.A; const char* cB = cur.B;
    PG8_STAGE(PG8_SB(0, 0), cB, voffB); PG8_STAGE(PG8_SB(0, 1), cB + hstepB, voffB); PG8_STAGE(PG8_SA(0, 0), cA, voffA); PG8_STAGE(PG8_SA(0, 1), cA + hstepA, voffA);
    if (wr == 1) PG8_BAR;
    PG8_WAIT_V(2); PG8_BAR;
    PG8_STAGE(PG8_SB(1, 0), cB + kstep, voffB); PG8_STAGE(PG8_SA(1, 0), cA + kstep, voffA); PG8_STAGE(PG8_SB(1, 1), cB + hstepB + kstep, voffB);
    PG8_WAIT_V(6); PG8_BAR;
    for (;;) {
        const bool has_next = S.next(ui + 1, nxt);
        const char* nA = has_next ? nxt.A : cA; const char* nB = has_next ? nxt.B : cB;
        const int nt = cur.nt;
        for (int t = 0; t < nt; t += 2) {
            const bool last = (t == nt - 2);
            const char* a1 = cA + (size_t)(t + 1) * kstep;
            const char* a2 = last ? nA : cA + (size_t)(t + 2) * kstep; const char* b2 = last ? nB : cB + (size_t)(t + 2) * kstep;
            const char* a3 = a2 + kstep; const char* b3 = b2 + kstep;
            PG8_LDB(B0, 0, 0); PG8_LDB(B1, 0, 1); PG8_SCHED; PG8_LDA(At, 0, 0); PG8_STAGE(PG8_SA(1, 1), a1 + hstepA, voffA);
            PG8_WAIT_V(8); PG8_WAIT_L(0); PG8_BAR; PG8_MMA(0, 0, At, B0); PG8_MMA(0, 1, At, B1); PG8_BAR; PG8_SCHED;
            PG8_LDA(At, 0, 1); PG8_STAGE(PG8_SB(0, 0), b2, voffB); PG8_STAGE(PG8_SB(0, 1), b2 + hstepB, voffB); PG8_STAGE(PG8_SA(0, 0), a2, voffA);
            PG8_WAIT_V(8); PG8_WAIT_L(0); PG8_BAR; PG8_MMA(1, 0, At, B0); PG8_MMA(1, 1, At, B1); PG8_BAR; PG8_SCHED;
            PG8_LDB(B0, 1, 0); PG8_LDB(B1, 1, 1); PG8_SCHED; PG8_LDA(At, 1, 0); PG8_STAGE(PG8_SA(0, 1), a2 + hstepA, voffA);
            PG8_WAIT_V(8); PG8_WAIT_L(0); PG8_BAR; PG8_MMA(0, 0, At, B0); PG8_MMA(0, 1, At, B1); PG8_BAR; PG8_SCHED;
            PG8_LDA(At, 1, 1); PG8_STAGE(PG8_SB(1, 0), b3, voffB); PG8_STAGE(PG8_SB(1, 1), b3 + hstepB, voffB); PG8_STAGE(PG8_SA(1, 0), a3, voffA);
            PG8_WAIT_V(8); PG8_WAIT_L(0); PG8_BAR; PG8_MMA(1, 0, At, B0); PG8_MMA(1, 1, At, B1); PG8_BAR; PG8_SCHED;
        }
        if (wr == 0) PG8_BAR;
        E(acc, cur, wr, wc, fr, fq);
        if (!has_next) break;
#pragma unroll
        for (int a = 0; a < 2; ++a)
#pragma unroll
            for (int b = 0; b < 2; ++b)
#pragma unroll
                for (int m = 0; m < 4; ++m)
#pragma unroll
                    for (int n = 0; n < 2; ++n) acc[a][b][m][n] = (f32x4){0.f, 0.f, 0.f, 0.f};
        cur = nxt; cA = nA; cB = nB; ++ui;
        if (wr == 1) PG8_BAR;
    }
    PG8_WAIT_V(0);
    PG8_BAR;
#undef PG8_SA
#undef PG8_SB
#undef PG8_STAGE
#undef PG8_LDA
#undef PG8_LDB
#undef PG8_MMA
#undef PG8_WAIT_V
#undef PG8_WAIT_L
#undef PG8_BAR
#undef PG8_SCHED
}

struct SchedGrid {
    int G, c, nM, nN, nt; const char* A; const char* B; size_t tsA, tsB; int rep;
    __device__ __forceinline__ bool next(int i, Unit& u) const {
        long L = (long)i * G + c; if (L >= (long)nM * nN * rep) return false; L %= (long)nM * nN;
        int pm, pn; tile_of((int)L, nM, nN, pm, pn);
        u.pm = pm; u.pn = pn; u.tag = 0; u.nt = nt; u.A = A + (size_t)pm * tsA; u.B = B + (size_t)pn * tsB; return true;
    }
};
struct SchedP2 {
    int G, c; const char* H; const char* W; int rep;
    __device__ __forceinline__ bool next(int i, Unit& u) const {
        long L = (long)i * G + c; if (L >= 64 * 13 * rep) return false; L %= 64 * 13;
        int pm, pn; tile_of((int)L, 64, 13, pm, pn);
        const size_t ts = (size_t)256 * 1024 * 2;
        u.pm = pm; u.pn = pn; u.tag = pn; u.nt = 16;
        if (pn < 11) { u.A = H + (size_t)pm * ts; u.B = W + 2 * ts + (size_t)pn * ts; }
        else { u.A = W + (size_t)(pn - 11) * ts; u.B = H + (size_t)pm * ts; }
        return true;
    }
};
struct SchedDft {
    int G, c; const char* D; const char* Z; int rep;
    __device__ __forceinline__ bool next(int i, Unit& u) const {
        const long Ll = (long)i * G + c; if (Ll >= 256 * rep) return false; const int L = (int)(Ll % 256);
        u.tag = 0;
        if (L < 128) { const int b = L >> 4, rem = L & 15, pmq = rem >> 2, cs = (rem >> 1) & 1, pnq = rem & 1;
            u.A = D + (size_t)cs * (1024 * 1024 * 2) + (size_t)pmq * (256 * 1024 * 2);
            u.B = Z + ((size_t)pnq * 256 * 16384 + 8192 + b * 1024) * 2; u.nt = 16; u.pm = 32 + b * 4 + pmq; u.pn = cs * 2 + pnq; }
        else { const int L2 = L - 128, b = L2 >> 2, cs = (L2 >> 1) & 1, pnq = L2 & 1;
            u.A = D + (size_t)2 * (1024 * 1024 * 2) + (size_t)cs * (256 * 1024 * 2);
            u.B = Z + ((size_t)pnq * 256 * 16384 + b * 256) * 2; u.nt = 4; u.pm = b; u.pn = cs * 2 + pnq; }
        return true;
    }
};
struct SchedP4 {
    int G, c; const char* X; const char* W; int rep;
    __device__ __forceinline__ bool next(int i, Unit& u) const {
        long Lt = (long)(i >> 1) * G + c; if (Lt >= 256 * rep) return false; Lt %= 256;
        int pm, pn; tile_of((int)Lt, 64, 4, pm, pn); const int sub = i & 1;
        u.pm = pm; u.pn = pn; u.tag = sub; u.nt = sub ? 8 : 16;
        u.A = X + (size_t)pm * 256 * 1536 * 2 + (sub ? 2048 : 0); u.B = W + (size_t)pn * 256 * 1536 * 2 + (sub ? 2048 : 0); return true;
    }
};

struct EpiP2 {
    static constexpr bool PERM = false;
    bf16_t *Q, *Kb, *Vb, *Gt, *ZT; float *ock, *ocv; const float *gq, *gk, *ropeC, *ropeS;
    __device__ __forceinline__ void operator()(const f32x4 (&acc)[2][2][4][2], const Unit& u, int wr, int wc, int fr, int fq) const {
        const int pn = u.pn;
        if (pn >= 11) {
            const int ch0 = (pn - 11) * 256 + wr * 64 + fr, tok0 = u.pm * 256 + wc * 32 + 4 * fq;
#pragma unroll
            for (int ai = 0; ai < 2; ++ai)
#pragma unroll
                for (int m = 0; m < 4; ++m) { bf16_t* rowp = ZT + (size_t)(ch0 + ai * 128 + m * 16) * 16384 + tok0;
#pragma unroll
                    for (int bj = 0; bj < 2; ++bj)
#pragma unroll
                        for (int n = 0; n < 2; ++n) { const f32x4 v = acc[ai][bj][m][n]; u32x2 w; w.x = cvt_pk_bf16(v[0], v[1]); w.y = cvt_pk_bf16(v[2], v[3]); *(u32x2*)(rowp + bj * 128 + n * 16) = w; } }
        } else if (pn >= 3) {
            const int row0 = u.pm * 256 + wr * 64 + fr, col0 = (pn - 3) * 256 + wc * 32 + 8 * fq;
#pragma unroll
            for (int ai = 0; ai < 2; ++ai)
#pragma unroll
                for (int m = 0; m < 4; ++m) { bf16_t* rowp = Gt + (size_t)(row0 + ai * 128 + m * 16) * 2048 + col0;
#pragma unroll
                    for (int bj = 0; bj < 2; ++bj) { float sg[8];
#pragma unroll
                        for (int n = 0; n < 2; ++n)
#pragma unroll
                            for (int j = 0; j < 4; ++j) sg[4 * n + j] = __builtin_amdgcn_rcpf(1.f + __expf(-acc[ai][bj][m][n][j]));
                        u32x4 w; w.x = cvt_pk_bf16(sg[0], sg[1]); w.y = cvt_pk_bf16(sg[2], sg[3]); w.z = cvt_pk_bf16(sg[4], sg[5]); w.w = cvt_pk_bf16(sg[6], sg[7]);
                        *(u32x4*)(rowp + bj * 128) = w; } }
        } else {
            const bool lat = u.pm >= 32, isv = (pn == 2 && wc >= 2);
            f32x4 g[2][2];
#pragma unroll
            for (int bj = 0; bj < 2; ++bj)
#pragma unroll
                for (int n = 0; n < 2; ++n) { const f32x4 ga = *(const f32x4*)(gq + 32 * bj + 16 * n + 4 * fq), gb = *(const f32x4*)(gk + 32 * bj + 16 * n + 4 * fq); g[bj][n] = pn < 2 ? ga : gb; }
#pragma unroll
            for (int ai = 0; ai < 2; ++ai)
#pragma unroll
                for (int m = 0; m < 4; ++m) {
                    const int r = u.pm * 256 + ai * 128 + wr * 64 + m * 16 + fr;
                    f32x4 v[2][2];
#pragma unroll
                    for (int bj = 0; bj < 2; ++bj)
#pragma unroll
                        for (int n = 0; n < 2; ++n) v[bj][n] = acc[ai][bj][m][n];
                    if (!isv) {
                        float ss = 0.f;
#pragma unroll
                        for (int bj = 0; bj < 2; ++bj)
#pragma unroll
                            for (int n = 0; n < 2; ++n) { const f32x4 x = v[bj][n]; ss += (x[0] * x[0] + x[1] * x[1]) + (x[2] * x[2] + x[3] * x[3]); }
                        ss += __shfl_xor(ss, 16); ss += __shfl_xor(ss, 32);
                        const float rstd = rsqrtf(ss * (1.f / 64.f) + 1e-6f);
#pragma unroll
                        for (int bj = 0; bj < 2; ++bj)
#pragma unroll
                            for (int n = 0; n < 2; ++n) v[bj][n] = v[bj][n] * rstd * g[bj][n];
                    }
                    if (pn == 2 && !lat) {
                        float* o = ock + (isv ? (size_t)NPROMPT * 128 : (size_t)0) + (size_t)r * 128 + (wc & 1) * 64 + 4 * fq;
#pragma unroll
                        for (int bj = 0; bj < 2; ++bj)
#pragma unroll
                            for (int n = 0; n < 2; ++n) *(f32x4*)(o + 32 * bj + 16 * n) = v[bj][n];
                    }
                    if (!isv && lat) {
                        const int s = (r - NPROMPT) & 1023;
#pragma unroll
                        for (int bj = 0; bj < 2; ++bj) { const int pos = bj ? (s & 63) : (s >> 6);
                            const f32x4 ct = *(const f32x4*)(ropeC + pos * 16 + 4 * fq), sn = *(const f32x4*)(ropeS + pos * 16 + 4 * fq);
                            const f32x4 x1 = v[bj][0], x2 = v[bj][1]; v[bj][0] = x1 * ct - x2 * sn; v[bj][1] = x1 * sn + x2 * ct; }
                    }
                    const size_t doff = (pn < 2) ? (size_t)r * 512 + (4 * pn + wc) * 64 : (isv ? (WS_V - WS_Q) / 2 : (WS_K - WS_Q) / 2) + (size_t)r * 128 + (wc & 1) * 64;
                    bf16_t* dst = Q + doff;
#pragma unroll
                    for (int bj = 0; bj < 2; ++bj)
#pragma unroll
                        for (int n = 0; n < 2; ++n) { const f32x4 x = v[bj][n]; u32x2 w; w.x = cvt_pk_bf16(x[0], x[1]); w.y = cvt_pk_bf16(x[2], x[3]); *(u32x2*)(dst + 32 * bj + 16 * n + 4 * fq) = w; }
                }
        }
    }
};
struct EpiStore {
    static constexpr bool PERM = true;
    bf16_t* O; int ldc;
    __device__ __forceinline__ void operator()(const f32x4 (&acc)[2][2][4][2], const Unit& u, int wr, int wc, int fr, int fq) const {
        const int row0 = u.pm * 256 + wr * 64 + fr, col0 = u.pn * 256 + wc * 32 + 8 * fq;
#pragma unroll
        for (int ai = 0; ai < 2; ++ai)
#pragma unroll
            for (int m = 0; m < 4; ++m) { bf16_t* rowp = O + (size_t)(row0 + ai * 128 + m * 16) * ldc + col0;
#pragma unroll
                for (int bj = 0; bj < 2; ++bj) { const f32x4 v0 = acc[ai][bj][m][0], v1 = acc[ai][bj][m][1];
                    u32x4 w; w.x = cvt_pk_bf16(v0[0], v0[1]); w.y = cvt_pk_bf16(v0[2], v0[3]); w.z = cvt_pk_bf16(v1[0], v1[1]); w.w = cvt_pk_bf16(v1[2], v1[3]);
                    *(u32x4*)(rowp + bj * 128) = w; } }
    }
};
struct EpiP4 {
    static constexpr bool PERM = true;
    bf16_t* T; const bf16_t* Gt;
    static constexpr long MRG_OFF = ((long)WS_H - (long)WS_T) / 2;
    __device__ __forceinline__ void operator()(const f32x4 (&acc)[2][2][4][2], const Unit& u, int wr, int wc, int fr, int fq) const {
        const int row0 = u.pm * 256 + wr * 64 + fr, col0 = u.pn * 256 + wc * 32 + 8 * fq; const int sub = u.tag;
#pragma unroll
        for (int ai = 0; ai < 2; ++ai)
#pragma unroll
            for (int m = 0; m < 4; ++m) { const size_t r = (size_t)(row0 + ai * 128 + m * 16);
#pragma unroll
                for (int bj = 0; bj < 2; ++bj) { const int c = col0 + bj * 128; const f32x4 v0 = acc[ai][bj][m][0], v1 = acc[ai][bj][m][1];
                    const u32x4 gw = *(const u32x4*)(Gt + r * 2048 + (sub ? 1024 : 0) + c);
                    float o[8] = { v0[0] * bf_lo(gw.x), v0[1] * bf_hi(gw.x), v0[2] * bf_lo(gw.y), v0[3] * bf_hi(gw.y), v1[0] * bf_lo(gw.z), v1[1] * bf_hi(gw.z), v1[2] * bf_lo(gw.w), v1[3] * bf_hi(gw.w) };
                    if (sub) { const u32x4 tw = *(const u32x4*)(T + r * 1024 + c);
                        o[0] += bf_lo(tw.x); o[1] += bf_hi(tw.x); o[2] += bf_lo(tw.y); o[3] += bf_hi(tw.y); o[4] += bf_lo(tw.z); o[5] += bf_hi(tw.z); o[6] += bf_lo(tw.w); o[7] += bf_hi(tw.w); }
                    u32x4 w; w.x = cvt_pk_bf16(o[0], o[1]); w.y = cvt_pk_bf16(o[2], o[3]); w.z = cvt_pk_bf16(o[4], o[5]); w.w = cvt_pk_bf16(o[6], o[7]);
                    *(u32x4*)(T + ((long)(sub ? MRG_OFF : 0L) + (long)(r * 1024 + c))) = w; } }
    }
};
struct EpiRes {
    static constexpr bool PERM = false;
    const float *bp, *bs; float* out; const float* gate;
    __device__ __forceinline__ void operator()(const f32x4 (&acc)[2][2][4][2], const Unit& u, int wr, int wc, int fr, int fq) const {
        const int v = u.pm < 32 ? 0 : 1 + ((u.pm - 32) >> 2);
        const int col0 = u.pn * 256 + wc * 32 + 4 * fq;
        f32x4 gt[2][2];
#pragma unroll
        for (int bj = 0; bj < 2; ++bj)
#pragma unroll
            for (int n = 0; n < 2; ++n) gt[bj][n] = *(const f32x4*)(gate + (size_t)v * 6144 + col0 + bj * 128 + n * 16);
#pragma unroll
        for (int ai = 0; ai < 2; ++ai)
#pragma unroll
            for (int m = 0; m < 4; ++m) { const int r = u.pm * 256 + ai * 128 + wr * 64 + m * 16 + fr;
                const float* b = (u.pm < 32 ? bp + (size_t)r * 1024 : bs + (size_t)(r - NPROMPT) * 1024) + col0; float* o = out + (size_t)r * 1024 + col0;
#pragma unroll
                for (int bj = 0; bj < 2; ++bj)
#pragma unroll
                    for (int n = 0; n < 2; ++n) { const f32x4 x = *(const f32x4*)(b + bj * 128 + n * 16); *(f32x4*)(o + bj * 128 + n * 16) = x + gt[bj][n] * acc[ai][bj][m][n]; } }
    }
};
struct EpiSwiglu {
    static constexpr bool PERM = true;
    bf16_t* O;
    __device__ __forceinline__ void operator()(const f32x4 (&acc)[2][2][4][2], const Unit& u, int wr, int wc, int fr, int fq) const {
        const int row0 = u.pm * 256 + wr * 64 + fr, col0 = u.pn * 128 + wc * 32 + 8 * fq;
#pragma unroll
        for (int ai = 0; ai < 2; ++ai)
#pragma unroll
            for (int m = 0; m < 4; ++m) { float o[8];
#pragma unroll
                for (int n = 0; n < 2; ++n)
#pragma unroll
                    for (int j = 0; j < 4; ++j) { const float a = acc[ai][0][m][n][j], uu = acc[ai][1][m][n][j]; o[4 * n + j] = a * __builtin_amdgcn_rcpf(1.f + __expf(-a)) * uu; }
                u32x4 w; w.x = cvt_pk_bf16(o[0], o[1]); w.y = cvt_pk_bf16(o[2], o[3]); w.z = cvt_pk_bf16(o[4], o[5]); w.w = cvt_pk_bf16(o[6], o[7]);
                *(u32x4*)(O + (size_t)(row0 + ai * 128 + m * 16) * DFF + col0) = w; }
    }
};
}

constexpr int AT_P = 72;
constexpr int AT_KS = 0, AT_VT = 64 * AT_P * 2, AT_PW = 2 * 64 * AT_P * 2, AT_WB = 64 * AT_P * 2;
__device__ __forceinline__ void attn_unit(LAS unsigned char* lds, int unit, const bf16_t* Q, const bf16_t* Kb, const bf16_t* Vb, const bf16_t* CK, const bf16_t* CV,
                                          bf16_t* O, const float* sinks, int tid, int wave, int lane) {
    const int fr = lane & 15, fq = lane >> 4;
    int qrow_base, kvh, nb = 0, krow_base, crow_base = 0; bool lat;
    if (unit < 128) { const int b = unit >> 2; kvh = (unit >> 1) & 1; qrow_base = b * 256 + (unit & 1) * 128; krow_base = b * 256; lat = false; }
    else { const int u2 = unit - 128, b = u2 >> 4; kvh = (u2 >> 3) & 1; nb = u2 & 7; qrow_base = NPROMPT + b * 1024 + nb * 128; krow_base = NPROMPT + b * 1024; crow_base = b * 256; lat = true; }
    const int g = wave >> 1, th = wave & 1, h = kvh * 4 + g;
    const int qrow0 = qrow_base + th * 64;
    bf16x8 qf[4][2];
#pragma unroll
    for (int qi = 0; qi < 4; ++qi)
#pragma unroll
        for (int s = 0; s < 2; ++s) { const bf16_t* Qu = Q + (size_t)qrow0 * 512 + h * 64; qf[qi][s] = *(const bf16x8*)(Qu + (unsigned)((qi * 16 + fr) * 512 + s * 32 + fq * 8)); }
    const float L2E = 1.4426950408889634f, sc = 0.125f * L2E;
    float m_[4], l_[4]; const float sk = sinks[h] * L2E;
#pragma unroll
    for (int qi = 0; qi < 4; ++qi) { m_[qi] = sk; l_[qi] = (fq == 0) ? 1.f : 0.f; }
    f32x4 o[4][4];
#pragma unroll
    for (int a = 0; a < 4; ++a)
#pragma unroll
        for (int b = 0; b < 4; ++b) o[a][b] = (f32x4){0.f, 0.f, 0.f, 0.f};
    LAS unsigned char* Pw = lds + AT_PW + wave * AT_WB;
    const int ntl = lat ? 6 : 0, ntot = ntl + 4;
#define AT_TILE(t, KS_, VS_, KT_, OK_) do { OK_ = true; KT_ = 0; if ((t) < ntl) { KT_ = 128 * (nb - 1) + 64 * (t); if (KT_ < 0 || KT_ >= 1024) OK_ = false; \
            const size_t ro_ = (size_t)(krow_base + (OK_ ? KT_ : 0)) * 128; KS_ = Kb + ro_; VS_ = Vb + ro_; } \
        else { const size_t ro_ = (size_t)((lat ? crow_base : krow_base) + ((t) - ntl) * 64) * 128; KS_ = (lat ? CK : Kb) + ro_; VS_ = (lat ? CV : Vb) + ro_; } } while (0)
    int tcur = 0; const bf16_t *ksrc, *vsrc; int ktok0; bool ok;
    for (;; ++tcur) { AT_TILE(tcur, ksrc, vsrc, ktok0, ok); if (ok) break; }
    const unsigned kofs = (unsigned)((tid >> 3) * 128 + kvh * 64 + (tid & 7) * 8), vofs = (unsigned)(lane * 128 + kvh * 64 + wave * 8);
    u32x4 kreg = *(const u32x4*)(ksrc + kofs);
    u32x4 vreg = *(const u32x4*)(vsrc + vofs);
    while (tcur < ntot) {
        const bool masked = (tcur < ntl) && (tcur < 2 || tcur >= 4); const int ktokc = ktok0;
        __syncthreads();
        { const int key = tid >> 3, ch = tid & 7;
          *(LAS u32x4*)(lds + AT_KS + (key * AT_P + ch * 8) * 2) = kreg;
          LAS unsigned short* vt = (LAS unsigned short*)(lds + AT_VT) + (wave * 8) * AT_P + lane;
          vt[0 * AT_P] = (unsigned short)(vreg.x & 0xffffu); vt[1 * AT_P] = (unsigned short)(vreg.x >> 16);
          vt[2 * AT_P] = (unsigned short)(vreg.y & 0xffffu); vt[3 * AT_P] = (unsigned short)(vreg.y >> 16);
          vt[4 * AT_P] = (unsigned short)(vreg.z & 0xffffu); vt[5 * AT_P] = (unsigned short)(vreg.z >> 16);
          vt[6 * AT_P] = (unsigned short)(vreg.w & 0xffffu); vt[7 * AT_P] = (unsigned short)(vreg.w >> 16); }
        int tn = tcur + 1;
        for (; tn < ntot; ++tn) { AT_TILE(tn, ksrc, vsrc, ktok0, ok); if (ok) break; }
        if (tn < ntot) { kreg = *(const u32x4*)(ksrc + kofs); vreg = *(const u32x4*)(vsrc + vofs); }
        __syncthreads();
#pragma unroll
        for (int qh = 0; qh < 2; ++qh) {
        f32x4 st[4][2];
#pragma unroll
        for (int kb = 0; kb < 4; ++kb) {
            const bf16x8 k0 = *(const LAS bf16x8*)(lds + AT_KS + ((kb * 16 + fr) * AT_P + fq * 8) * 2), k1 = *(const LAS bf16x8*)(lds + AT_KS + ((kb * 16 + fr) * AT_P + 32 + fq * 8) * 2);
#pragma unroll
            for (int q2 = 0; q2 < 2; ++q2) { f32x4 a = (f32x4){0.f, 0.f, 0.f, 0.f};
                a = __builtin_amdgcn_mfma_f32_16x16x32_bf16(k0, qf[2 * qh + q2][0], a, 0, 0, 0); a = __builtin_amdgcn_mfma_f32_16x16x32_bf16(k1, qf[2 * qh + q2][1], a, 0, 0, 0); st[kb][q2] = a; }
        }
#pragma unroll
        for (int q2 = 0; q2 < 2; ++q2) { const int qi = 2 * qh + q2;
            float mx = -INFINITY;
            if (masked) { const int qt = nb * 128 + th * 64 + qi * 16 + fr;
#pragma unroll
                for (int kb = 0; kb < 4; ++kb)
#pragma unroll
                    for (int j = 0; j < 4; ++j) { const int d = qt - (ktokc + kb * 16 + fq * 4 + j); if (d > 128 || d < -128) st[kb][q2][j] = -INFINITY; } }
#pragma unroll
            for (int kb = 0; kb < 4; ++kb) mx = fmaxf(fmaxf(mx, fmaxf(st[kb][q2][0], st[kb][q2][1])), fmaxf(st[kb][q2][2], st[kb][q2][3]));
            mx = fmaxf(mx, __shfl_xor(mx, 16)); mx = fmaxf(mx, __shfl_xor(mx, 32));
            const float mnew = fmaxf(m_[qi], mx * sc), alpha = __builtin_amdgcn_exp2f(m_[qi] - mnew); m_[qi] = mnew;
            float rs = 0.f;
#pragma unroll
            for (int kb = 0; kb < 4; ++kb) { f32x4 p;
#pragma unroll
                for (int j = 0; j < 4; ++j) { p[j] = __builtin_amdgcn_exp2f(__builtin_fmaf(st[kb][q2][j], sc, -mnew)); rs += p[j]; }
                u32x2 w; w.x = cvt_pk_bf16(p[0], p[1]); w.y = cvt_pk_bf16(p[2], p[3]);
                *(LAS u32x2*)(Pw + ((qi * 16 + fr) * AT_P + kb * 16 + fq * 4) * 2) = w; }
            l_[qi] = l_[qi] * alpha + rs;
#pragma unroll
            for (int db = 0; db < 4; ++db) o[db][qi] = o[db][qi] * alpha;
        }
        __builtin_amdgcn_sched_barrier(0);
        }
        asm volatile("s_waitcnt lgkmcnt(0)" ::: "memory");
#pragma unroll
        for (int s2 = 0; s2 < 2; ++s2) {
            bf16x8 pf[4];
#pragma unroll
            for (int qi = 0; qi < 4; ++qi) pf[qi] = *(const LAS bf16x8*)(Pw + ((qi * 16 + fr) * AT_P + s2 * 32 + fq * 8) * 2);
#pragma unroll
            for (int db = 0; db < 4; ++db) { const bf16x8 vf = *(const LAS bf16x8*)(lds + AT_VT + ((db * 16 + fr) * AT_P + s2 * 32 + fq * 8) * 2);
#pragma unroll
                for (int qi = 0; qi < 4; ++qi) o[db][qi] = __builtin_amdgcn_mfma_f32_16x16x32_bf16(vf, pf[qi], o[db][qi], 0, 0, 0); }
        }
        tcur = tn;
    }
#undef AT_TILE
    int fr2 = lane & 15, fq2 = lane >> 4; asm volatile("" : "+v"(fr2), "+v"(fq2));
#pragma unroll
    for (int qi = 0; qi < 4; ++qi) { float lt = l_[qi]; lt += __shfl_xor(lt, 16); lt += __shfl_xor(lt, 32); const float inv = 1.f / lt;
        bf16_t* Ou = O + (size_t)qrow0 * 1536 + h * 64; bf16_t* dst = Ou + (unsigned)((qi * 16 + fr2) * 1536 + fq2 * 4);
#pragma unroll
        for (int db = 0; db < 4; ++db) { const f32x4 v = o[db][qi] * inv; u32x2 w; w.x = cvt_pk_bf16(v[0], v[1]); w.y = cvt_pk_bf16(v[2], v[3]); *(u32x2*)(dst + db * 16) = w; } }
}

__device__ __forceinline__ float wave_sum(float v) {
#pragma unroll
    for (int o = 1; o < 64; o <<= 1) v += __shfl_xor(v, o);
    return v;
}
__device__ __forceinline__ int dest_row(int c, int mode) {
    if (mode == 1) { if (c < 512) return c; if (c >= 1280) { const int g = c & ~31, q = c & 31, a = q >> 3, n = (q >> 2) & 1, b = q & 3; return g + 16 * n + 4 * a + b; }   const int c2 = c - 512, pn = c2 >> 8, a = c2 & 255, wc = a >> 6, bj = (a >> 5) & 1; return 512 + 256 * pn + 128 * bj + 32 * wc + (a & 31); }
    if (mode == 2) { if (c < DFF) return 256 * (c >> 7) + (c & 127); const int j = c - DFF; return 256 * (j >> 7) + 128 + (j & 127); }
    return c;
}
__device__ __forceinline__ void p0_transpose_item(const float* W, int K, int N, bf16_t* WT, int ldw, int koff, int mode, LAS float* scr, int item, int lane) {
    const int nblk = N / 32, kb = item / nblk, nbk = item % nblk, k0 = 64 * kb, n0 = 32 * nbk;
    const unsigned lo_ = (unsigned)((lane >> 5) * N + (lane & 31));
#pragma unroll
    for (int h = 0; h < 2; ++h) { float t[16];
#pragma unroll
        for (int i = 0; i < 16; ++i) { const float* rowp = W + (size_t)(k0 + 2 * (16 * h + i)) * N + n0; t[i] = rowp[lo_]; }
#pragma unroll
        for (int i = 0; i < 16; ++i) scr[(2 * (16 * h + i) + (lane >> 5)) * 33 + (lane & 31)] = t[i]; }
    asm volatile("s_waitcnt lgkmcnt(0)" ::: "memory");
    const int c = lane & 7;
#pragma unroll
    for (int j = 0; j < 4; ++j) { const int n = (lane >> 3) + 8 * j; const LAS float* s = scr + (8 * c) * 33 + n;
        u32x4 o; o.x = f2bf(s[0 * 33]) | (f2bf(s[1 * 33]) << 16); o.y = f2bf(s[2 * 33]) | (f2bf(s[3 * 33]) << 16); o.z = f2bf(s[4 * 33]) | (f2bf(s[5 * 33]) << 16); o.w = f2bf(s[6 * 33]) | (f2bf(s[7 * 33]) << 16);
        *(u32x4*)(WT + (size_t)dest_row(n0 + n, mode) * ldw + koff + k0 + 8 * c) = o; }
    asm volatile("s_waitcnt lgkmcnt(0)" ::: "memory");
}
__device__ __forceinline__ void p0_fold_item(const float* wf, bf16_t* Wcat, LAS float* scr, int item, int lane) {
    const int g = item >> 8, o0 = (item & 255) * 4;
    LAS float* tw = scr;
    LAS float* tc = scr + 512;
    LAS float* ts = scr + 640;
#pragma unroll
    for (int i = 0; i < 2; ++i) { const int l = lane + 64 * i; const f32x4 v = *(const f32x4*)(wf + (size_t)(g * 128 + l) * 1024 + o0); *(LAS f32x4*)(tw + l * 4) = v;
        tc[l] = cospif((float)l * (1.f / 64.f)); ts[l] = sinpif((float)l * (1.f / 64.f)); }
    asm volatile("s_waitcnt lgkmcnt(0)" ::: "memory");
    float ce[4], co[4], se[4], so[4];
#pragma unroll
    for (int j = 0; j < 4; ++j) { ce[j] = 0.f; co[j] = 0.f; se[j] = 0.f; so[j] = 0.f; }
    const int c = lane;
#pragma unroll 4
    for (int l = 0; l < 128; l += 2) {
        { const int idx = (l * c) & 127; const float cv = tc[idx], sv = ts[idx]; const f32x4 w = *(const LAS f32x4*)(tw + l * 4);
#pragma unroll
          for (int j = 0; j < 4; ++j) { ce[j] += cv * w[j]; se[j] += sv * w[j]; } }
        { const int idx = ((l + 1) * c) & 127; const float cv = tc[idx], sv = ts[idx]; const f32x4 w = *(const LAS f32x4*)(tw + (l + 1) * 4);
#pragma unroll
          for (int j = 0; j < 4; ++j) { co[j] += cv * w[j]; so[j] += sv * w[j]; } }
    }
    const float sc = 0.08838834764831845f;
#pragma unroll
    for (int j = 0; j < 4; ++j) { bf16_t* row = Wcat + (size_t)(o0 + j) * 1536 + g * 128;
        row[c] = (bf16_t)f2bf((ce[j] + co[j]) * sc); row[c + 64] = (bf16_t)f2bf((ce[j] - co[j]) * sc);
        row[512 + c] = (bf16_t)f2bf(-(se[j] + so[j]) * sc); row[512 + c + 64] = (bf16_t)f2bf(-(se[j] - so[j]) * sc); }
    asm volatile("s_waitcnt lgkmcnt(0)" ::: "memory");
}
__device__ __forceinline__ void p0_ada_item(const float* w_ada, const float* c_lat, const float* c_ctx, float* part, LAS float* scr, int item, int lane) {
    const int cc = item % 96, ic = item / 96, j = cc * 64 + lane, i0 = ic * 128;
#pragma unroll
    for (int v = 0; v < 9; ++v)
#pragma unroll
        for (int hh = 0; hh < 2; ++hh) { const int i = lane + 64 * hh; const float x = (v == 0) ? c_ctx[i0 + i] : c_lat[(v - 1) * 1024 + i0 + i]; scr[v * 128 + i] = x / (1.f + __expf(-x)); }
    asm volatile("s_waitcnt lgkmcnt(0)" ::: "memory");
    float acc[9];
#pragma unroll
    for (int v = 0; v < 9; ++v) acc[v] = 0.f;
#pragma unroll 1
    for (int i = 0; i < 128; i += 16) { float w[16];
#pragma unroll
        for (int q = 0; q < 16; ++q) { const float* rowp = w_ada + (size_t)(i0 + i + q) * 6144 + cc * 64; w[q] = rowp[lane]; }
#pragma unroll
        for (int q = 0; q < 16; q += 4)
#pragma unroll
            for (int v = 0; v < 9; ++v) { const f32x4 sv = *(const LAS f32x4*)(scr + v * 128 + i + q); acc[v] += (sv[0] * w[q] + sv[1] * w[q + 1]) + (sv[2] * w[q + 2] + sv[3] * w[q + 3]); } }
#pragma unroll
    for (int v = 0; v < 9; ++v) part[((size_t)ic * 9 + v) * 6144 + j] = acc[v];
    asm volatile("s_waitcnt lgkmcnt(0)" ::: "memory");
}

__device__ __forceinline__ void norm_chunk(LAS unsigned char* lds, int chunk, const float* xp, const float* xs, const float* gnorm, const float* modsrc, const float* b_ada, bool partials,
                                           int off_shift, int off_scale, bf16_t* out, int tid, int wave, int lane) {
    const int row0 = chunk * 64; const int v = row0 < NPROMPT ? 0 : 1 + ((row0 - NPROMPT) >> 10);
    LAS float* la = (LAS float*)lds; LAS float* ls = la + 1024;
    __syncthreads();
    for (int col = tid; col < 1024; col += 512) {
        float sc, sh;
        if (partials) { sc = b_ada[off_scale + col]; sh = b_ada[off_shift + col];
#pragma unroll
            for (int p = 0; p < 8; ++p) { sc += modsrc[((size_t)p * 9 + v) * 6144 + off_scale + col]; sh += modsrc[((size_t)p * 9 + v) * 6144 + off_shift + col]; } }
        else { sc = modsrc[(size_t)v * 6144 + off_scale + col]; sh = modsrc[(size_t)v * 6144 + off_shift + col]; }
        la[col] = gnorm[col] * (1.f + sc); ls[col] = sh;
    }
    __syncthreads();
    for (int rr = 0; rr < 8; ++rr) {
        const int row = row0 + wave * 8 + rr;
        const float* xr = row < NPROMPT ? xp + (size_t)row * 1024 : xs + (size_t)(row - NPROMPT) * 1024;
        f32x4 x[4]; float ss = 0.f;
#pragma unroll
        for (int j = 0; j < 4; ++j) { x[j] = *(const f32x4*)(xr + 4 * lane + 256 * j); ss += (x[j][0] * x[j][0] + x[j][1] * x[j][1]) + (x[j][2] * x[j][2] + x[j][3] * x[j][3]); }
        const float rstd = rsqrtf(wave_sum(ss) * (1.f / 1024.f) + 1e-6f);
#pragma unroll
        for (int j = 0; j < 4; ++j) { const f32x4 a = *(const LAS f32x4*)(la + 4 * lane + 256 * j), s = *(const LAS f32x4*)(ls + 4 * lane + 256 * j);
            const f32x4 y = x[j] * rstd * a + s; u32x2 w; w.x = cvt_pk_bf16(y[0], y[1]); w.y = cvt_pk_bf16(y[2], y[3]);
            *(u32x2*)(out + (size_t)row * 1024 + 4 * lane + 256 * j) = w; }
    }
}

#define XB_TMO      128
#define XB_XCNT(j)  (256  + 64 * (j))
#define XB_XSUB(j)  (1280 + 64 * (j))
#define XB_XGEN(j)  (2304 + 64 * (j))
#define XB_TOP      3328
#define XB_TOPGEN   3392
#define XCD_BAR_WORDS 3456
#define XB_SPIN_CAP (1u << 18)

__device__ __forceinline__ unsigned xb_ld(unsigned* p)              { return __hip_atomic_load(p, __ATOMIC_RELAXED, __HIP_MEMORY_SCOPE_AGENT); }
__device__ __forceinline__ unsigned xb_add(unsigned* p, unsigned v) { return __hip_atomic_fetch_add(p, v, __ATOMIC_RELAXED, __HIP_MEMORY_SCOPE_AGENT); }
__device__ __forceinline__ unsigned xb_xcc_id() { return (unsigned)__builtin_amdgcn_s_getreg((3 << 11) | 20) & 0xFu; }
#define XB_SPIN(cond, bar) do { unsigned _sp = 0; while (cond) { __builtin_amdgcn_s_sleep(1); \
    if ((++_sp & 255u) == 0u) { if (xb_ld(&(bar)[XB_TMO])) break; if (_sp > XB_SPIN_CAP) { atomicAdd(&(bar)[XB_TMO], 1u); break; } } } } while (0)

struct XcdBarrier {
    unsigned* bar; unsigned x;
    volatile LAS unsigned* st;
};

__device__ __forceinline__ XcdBarrier xcd_barrier_post(unsigned* bar, volatile LAS unsigned* st) {
    XcdBarrier b; b.bar = bar; b.x = xb_xcc_id(); b.st = st;
    if (threadIdx.x == 0) (void)xb_add(&bar[XB_XCNT(b.x)], 1u);
    return b;
}
__device__ __forceinline__ void xcd_barrier_complete(unsigned* bar, unsigned x, unsigned& nloc, unsigned& nx) {
    const unsigned G = gridDim.x * gridDim.y * gridDim.z;
    unsigned sum, cnt, mine, sp = 0u;
    for (;;) {
        sum = 0u; cnt = 0u; mine = 0u;
#pragma unroll
        for (unsigned j = 0; j < 16; ++j) { const unsigned c = xb_ld(&bar[XB_XCNT(j)]); sum += c; cnt += (c > 0u) ? 1u : 0u; mine = (j == x) ? c : mine; }
        if (sum == G) break;
        __builtin_amdgcn_s_sleep(1);
        if ((++sp & 255u) == 0u) { if (xb_ld(&bar[XB_TMO])) break; if (sp > XB_SPIN_CAP) { atomicAdd(&bar[XB_TMO], 1u); break; } }
    }
    nloc = mine > 0u ? mine : 1u; nx = cnt > 0u ? cnt : 1u;
}

__device__ __forceinline__ void xcd_barrier(const XcdBarrier& b) {
    asm volatile("s_waitcnt vmcnt(0)" ::: "memory");
    __syncthreads();
    if (threadIdx.x == 0) {
        unsigned* bar = b.bar;
        __builtin_amdgcn_s_waitcnt(0);
        unsigned nloc = b.st[0], nx = b.st[1];
        if (nloc == 0u) { xcd_barrier_complete(bar, b.x, nloc, nx); b.st[0] = nloc; b.st[1] = nx; }
        const unsigned old = xb_add(&bar[XB_XSUB(b.x)], 1u);
        const unsigned gen = old / nloc;
        if (old + 1u == (gen + 1u) * nloc) {
            __builtin_amdgcn_fence(__ATOMIC_RELEASE, "agent");
            asm volatile("s_waitcnt vmcnt(0)" ::: "memory");
            const unsigned og = xb_add(&bar[XB_TOP], 1u);
            const unsigned tg = og / nx;
            if (og + 1u == (tg + 1u) * nx) xb_add(&bar[XB_TOPGEN], 1u);
            else XB_SPIN(xb_ld(&bar[XB_TOPGEN]) == tg, bar);
            __builtin_amdgcn_fence(__ATOMIC_ACQUIRE, "agent");
            xb_add(&bar[XB_XGEN(b.x)], 1u);
            asm volatile("s_waitcnt vmcnt(0)" ::: "memory");
        } else {
            XB_SPIN(xb_ld(&bar[XB_XGEN(b.x)]) == gen, bar);
            __builtin_amdgcn_fence(__ATOMIC_ACQUIRE, "agent");
            asm volatile("s_waitcnt vmcnt(0)" ::: "memory");
        }
    }
    __syncthreads();
}

#define XL_SUB(j) (3456 + 64 * (j))
#define XL_GEN(j) (3456 + 1024 + 64 * (j))
__device__ __forceinline__ void xcd_local_barrier(const XcdBarrier& b) {
    asm volatile("s_waitcnt vmcnt(0)" ::: "memory");
    __syncthreads();
    if (threadIdx.x == 0) {
        unsigned* bar = b.bar; const unsigned nloc = b.st[0];
        const unsigned old = xb_add(&bar[XL_SUB(b.x)], 1u), gen = old / nloc;
        if (old + 1u == (gen + 1u) * nloc) xb_add(&bar[XL_GEN(b.x)], 1u);
        else XB_SPIN(xb_ld(&bar[XL_GEN(b.x)]) == gen, bar);
        __builtin_amdgcn_fence(__ATOMIC_ACQUIRE, "agent");
        asm volatile("s_waitcnt vmcnt(0)" ::: "memory");
    }
    __syncthreads();
}

struct Args { const float* in[19]; float* out; unsigned char* ws; int ph_lo, ph_hi; };
#ifndef MK_LAST
#define MK_LAST 9
#endif
constexpr int NPH = MK_LAST;

__global__ void __launch_bounds__(512, 2) mk_fwd(Args args) {
    extern __shared__ __attribute__((aligned(16))) unsigned char lds_raw[];
    LAS unsigned char* lds = (LAS unsigned char*)lds_raw;
    const int tid = threadIdx.x, lane = tid & 63, wave = __builtin_amdgcn_readfirstlane(tid >> 6);
    const int G = gridDim.x;
    unsigned char* ws = args.ws;
    const float* x_prompt = args.in[0]; const float* x_sample = args.in[1]; const float* cache_k = args.in[2]; const float* cache_v = args.in[3];
    const float* c_lat = args.in[4]; const float* c_ctx = args.in[5]; const float* w_ada = args.in[6]; const float* b_ada = args.in[7];
    const float* g_norm1 = args.in[8]; const float* g_norm2 = args.in[9]; const float* w_in = args.in[10]; const float* g_q = args.in[11]; const float* g_k = args.in[12];
    const float* sinks = args.in[13]; const float* w_f = args.in[14]; const float* w_ao = args.in[15]; const float* w_out = args.in[16]; const float* w_up = args.in[17]; const float* w_down = args.in[18];
    float* out = args.out;
    float* modp = (float*)(ws + WS_MODP); float* mod = (float*)(ws + WS_MOD); float* ropeC = (float*)(ws + WS_ROPE); float* ropeS = ropeC + 1024;
    bf16_t* Win = (bf16_t*)(ws + WS_WIN); bf16_t* Wcat = (bf16_t*)(ws + WS_WCAT); bf16_t* Wout = (bf16_t*)(ws + WS_WOUT); bf16_t* Wup = (bf16_t*)(ws + WS_WUP); bf16_t* Wdn = (bf16_t*)(ws + WS_WDN);
    bf16_t* Dft = (bf16_t*)(ws + WS_DFT); bf16_t* CK = (bf16_t*)(ws + WS_CK); bf16_t* CV = (bf16_t*)(ws + WS_CV);
    bf16_t* Hb = (bf16_t*)(ws + WS_H); bf16_t* ZT = (bf16_t*)(ws + WS_ZFT); bf16_t* Qb = (bf16_t*)(ws + WS_Q); bf16_t* Kb = (bf16_t*)(ws + WS_K); bf16_t* Vb = (bf16_t*)(ws + WS_V);
    bf16_t* Gt = (bf16_t*)(ws + WS_G); bf16_t* ABX = (bf16_t*)(ws + WS_ABX); bf16_t* Tb = (bf16_t*)(ws + WS_T); bf16_t* ACT = (bf16_t*)(ws + WS_ACT);
    float* out_ck = out + (size_t)MTOK * DM; float* out_cv = out_ck + (size_t)NPROMPT * 128;
    cg::grid_group grid = cg::this_grid();
    const int lo = args.ph_lo, hi = args.ph_hi;
#ifndef MK_REPEAT_MASK
#define MK_REPEAT_MASK 0
#endif
#if (MK_REPEAT_MASK >> 0) & 1
#define PH0 for (int rep_ = 0; rep_ < 2; ++rep_) if (IN(0))
#else
#define PH0 if (IN(0))
#endif
#if (MK_REPEAT_MASK >> 1) & 1
#define PH1 for (int rep_ = 0; rep_ < 2; ++rep_) if (IN(1))
#else
#define PH1 if (IN(1))
#endif
#if (MK_REPEAT_MASK >> 2) & 1
#define PH2 for (int rep_ = 0; rep_ < 2; ++rep_) if (IN(2))
#else
#define PH2 if (IN(2))
#endif
#if (MK_REPEAT_MASK >> 3) & 1
#define PH3 for (int rep_ = 0; rep_ < 2; ++rep_) if (IN(3))
#else
#define PH3 if (IN(3))
#endif
#if (MK_REPEAT_MASK >> 4) & 1
#define PH4 for (int rep_ = 0; rep_ < 2; ++rep_) if (IN(4))
#else
#define PH4 if (IN(4))
#endif
#if (MK_REPEAT_MASK >> 5) & 1
#define PH5 for (int rep_ = 0; rep_ < 2; ++rep_) if (IN(5))
#else
#define PH5 if (IN(5))
#endif
#if (MK_REPEAT_MASK >> 6) & 1
#define PH6 for (int rep_ = 0; rep_ < 2; ++rep_) if (IN(6))
#else
#define PH6 if (IN(6))
#endif
#if (MK_REPEAT_MASK >> 7) & 1
#define PH7 for (int rep_ = 0; rep_ < 2; ++rep_) if (IN(7))
#else
#define PH7 if (IN(7))
#endif
#define NREP(k) ((((MK_REPEAT_MASK) >> (k)) & 1) ? 2 : 1)
#define IN(k) (lo <= (k) && (k) < hi)
#define SEAM(k) do { if (IN(k) && IN((k) + 1)) xcd_barrier(bar); } while (0)
#define SEAM_L(k) do { if (IN(k) && IN((k) + 1)) { if (uni) xcd_local_barrier(bar); else xcd_barrier(bar); } } while (0)
    volatile LAS unsigned* bst = (volatile LAS unsigned*)(lds + 131072 + 1024);
    XcdBarrier bar; bar.bar = (unsigned*)ws; bar.x = xb_xcc_id(); bar.st = bst;
    if (tid == 0) {
        const unsigned rk = xb_add(&bar.bar[XB_XCNT(bar.x)], 1u);
        unsigned nloc, nx; xcd_barrier_complete(bar.bar, bar.x, nloc, nx);
        bool uni = (G == 256) && (bar.x < 8u);
        for (unsigned j = 0; j < 8; ++j) uni = uni && (xb_ld(&bar.bar[XB_XCNT(j)]) == 32u);
        bst[0] = nloc; bst[1] = nx; bst[2] = uni ? (rk * 8u + bar.x) : (unsigned)blockIdx.x; bst[3] = uni ? 1u : 0u; bst[4] = uni ? (bar.x * 32u + rk) : (unsigned)blockIdx.x;
    }
    __syncthreads();
    const int c = (int)bst[2];
    const bool uni = bst[3] != 0u;
    const int crow = (int)bst[4];
    if (lo < 0) grid.sync();

    if (NREP(10) == 2) { for (int i_ = 0; i_ < 8; ++i_) xcd_barrier(bar); }
    PH0 {
        LAS float* scr = (LAS float*)(lds + wave * 16384);
        const int gw = c * 8 + wave, NGW = G * 8;
        constexpr int I_ADA = 768, I_IN = 16 * (INW / 32);
        for (int it = gw; it < I_ADA + I_IN; it += NGW) {
            if (it < I_ADA) { p0_ada_item(w_ada, c_lat, c_ctx, modp, scr, it, lane); continue; }
            p0_transpose_item(w_in, 1024, INW, Win, 1024, 0, 1, scr, it - I_ADA, lane);
        }
        const int gt = c * 512 + tid, NGT = G * 512;
        for (int e = gt; e < 1024 * 1024; e += NGT) { const int k = e >> 10, n = e & 1023, idx = (k * n) & 1023; const float a = (float)idx * (1.f / 512.f);
            Dft[e] = (bf16_t)f2bf(cospif(a) * (1.f / 32.f)); Dft[1024 * 1024 + e] = (bf16_t)f2bf(sinpif(a) * (1.f / 32.f)); }
        for (int e = gt; e < 256 * 256; e += NGT) { const int k = e >> 8, n = e & 255, idx = (k * n) & 255; const float a = (float)idx * (1.f / 128.f);
            Dft[2 * 1024 * 1024 + k * 1024 + n] = (bf16_t)f2bf(cospif(a) * (1.f / 16.f)); Dft[2 * 1024 * 1024 + 256 * 1024 + k * 1024 + n] = (bf16_t)f2bf(sinpif(a) * (1.f / 16.f)); }
        for (int e = gt; e < 2048 * 128 / 4; e += NGT) { const f32x4 kx = *(const f32x4*)(cache_k + 4 * (size_t)e), vx = *(const f32x4*)(cache_v + 4 * (size_t)e);
            u32x2 w; w.x = cvt_pk_bf16(kx[0], kx[1]); w.y = cvt_pk_bf16(kx[2], kx[3]); *(u32x2*)(CK + 4 * (size_t)e) = w;
            w.x = cvt_pk_bf16(vx[0], vx[1]); w.y = cvt_pk_bf16(vx[2], vx[3]); *(u32x2*)(CV + 4 * (size_t)e) = w; }
        for (int e = gt; e < 1024; e += NGT) { const int pos = e >> 4, i = e & 15; const float inv = powf(10000.f, -(float)i * (1.f / 16.f)); const float ang = (float)pos * inv;
            ropeC[e] = cosf(ang); ropeS[e] = sinf(ang); }
    }
    SEAM(0);
    if (IN(1)) {
        for (int e = c * 512 + tid; e < 9 * 6144; e += G * 512) { const int v = e / 6144, j = e % 6144; float s = b_ada[j];
#pragma unroll
            for (int p = 0; p < 8; ++p) s += modp[((size_t)p * 9 + v) * 6144 + j];
            mod[e] = s; }
        for (int ch = crow; ch < 256 * NREP(1); ch += G) norm_chunk(lds, ch & 255, x_prompt, x_sample, g_norm1, modp, b_ada, true, 0, 1024, Hb, tid, wave, lane);
        __syncthreads();
    }
    SEAM_L(1);
    if (IN(2)) {
        pg8::SchedP2 S{G, c, (const char*)Hb, (const char*)Win, NREP(2)};
        pg8::EpiP2 E{Qb, Kb, Vb, Gt, ZT, out_ck, out_cv, g_q, g_k, ropeC, ropeS};
        pg8::gemm_phase<pg8::EpiP2, pg8::SchedP2>(lds, 1024, 1024, S, E);
        {
            const int nshort = (G == 256) ? 192 : G, sidx = (G == 256) ? c - 64 : c;
            if (sidx >= 0) {
                LAS float* scr = (LAS float*)(lds + wave * 16384);
                constexpr int I_FOLD = 1024, I_AO = 8 * 32, I_OUT = 16 * 32, I_UP = 16 * (2 * DFF / 32), I_DN = (DFF / 64) * 32;
                constexpr int NIT2 = I_FOLD + I_AO + I_OUT + I_UP + I_DN;
                for (int it = sidx * 8 + wave; it < NIT2; it += nshort * 8) {
                    int r = it;
                    if (r < I_FOLD) { p0_fold_item(w_f, Wcat, scr, r, lane); continue; } r -= I_FOLD;
                    const float* W; int K, N, ldw, koff, mode; bf16_t* WT;
                    if (r < I_AO) { W = w_ao; K = 512; N = 1024; WT = Wcat; ldw = 1536; koff = 1024; mode = 0; }
                    else if ((r -= I_AO) < I_OUT) { W = w_out; K = 1024; N = 1024; WT = Wout; ldw = 1024; koff = 0; mode = 0; }
                    else if ((r -= I_OUT) < I_UP) { W = w_up; K = 1024; N = 2 * DFF; WT = Wup; ldw = 1024; koff = 0; mode = 2; }
                    else { r -= I_UP; W = w_down; K = DFF; N = 1024; WT = Wdn; ldw = DFF; koff = 0; mode = 0; }
                    p0_transpose_item(W, K, N, WT, ldw, koff, mode, scr, r, lane);
                }
            }
        }
    }
    SEAM(2);
    if (IN(3)) {
        pg8::SchedDft S{G, c, (const char*)Dft, (const char*)ZT, NREP(3)};
        pg8::EpiStore E{ABX, 1536};
        pg8::gemm_phase<pg8::EpiStore, pg8::SchedDft>(lds, 1024, 16384, S, E);
        if (c < 256) attn_unit(lds, c, Qb, Kb, Vb, CK, CV, ABX + 1024, sinks, tid, wave, lane);
        __syncthreads();
    }
    SEAM(3);
#ifdef MK_DBG
    if (IN(4)) {
        for (size_t e = (size_t)c * 512 + tid; e < (size_t)MTOK * 1024; e += (size_t)G * 512) { const size_t r = e >> 10; const int cc = (int)(e & 1023);
            float v = 0.f;
            if (MK_DBG == 1) v = bf_lo(ABX[r * 1536 + cc]);
            else if (MK_DBG == 2) v = cc < 512 ? bf_lo(ABX[r * 1536 + 1024 + cc]) : 0.f;
            else if (MK_DBG == 4) v = (cc < 512 && r < 8192) ? bf_lo(ABX[r * 1536 + 1024 + cc]) : 0.f;
            else if (MK_DBG == 3) v = cc < 512 ? bf_lo(Qb[r * 512 + cc]) : (cc < 640 ? bf_lo(Kb[r * 128 + cc - 512]) : (cc < 768 ? bf_lo(Vb[r * 128 + cc - 640]) : (r < 2048 ? (cc < 896 ? bf_lo(CK[r * 128 + cc - 768]) : bf_lo(CV[r * 128 + cc - 896])) : 0.f)));
            out[e] = v; }
    }
#else
    if (IN(4)) {
        pg8::SchedP4 S{G, c, (const char*)ABX, (const char*)Wcat, NREP(4)};
        pg8::EpiP4 E{Tb, Gt};
        pg8::gemm_phase<pg8::EpiP4, pg8::SchedP4>(lds, 1536, 1536, S, E);
    }
#endif
    SEAM_L(4);
    if (IN(5)) {
        pg8::SchedGrid S{G, c, 64, 4, 16, (const char*)Hb, (const char*)Wout, (size_t)256 * 1024 * 2, (size_t)256 * 1024 * 2, NREP(5)};
        pg8::EpiRes E{x_prompt, x_sample, out, mod + 2048};
        pg8::gemm_phase<pg8::EpiRes, pg8::SchedGrid>(lds, 1024, 1024, S, E);
    }
    SEAM_L(5);
    if (IN(6)) {
        for (int ch = crow; ch < 256 * NREP(6); ch += G) norm_chunk(lds, ch & 255, out, out + (size_t)NPROMPT * 1024, g_norm2, mod, b_ada, false, 3072, 4096, Hb, tid, wave, lane);
        __syncthreads();
    }
    SEAM_L(6);
    if (IN(7)) {
        pg8::SchedGrid S{G, c, 64, 22, 16, (const char*)Hb, (const char*)Wup, (size_t)256 * 1024 * 2, (size_t)256 * 1024 * 2, NREP(7)};
        pg8::EpiSwiglu E{ACT};
        pg8::gemm_phase<pg8::EpiSwiglu, pg8::SchedGrid>(lds, 1024, 1024, S, E);
    }
    SEAM_L(7);
    if (IN(8)) {
        pg8::SchedGrid S{G, c, 64, 4, DFF / 64, (const char*)ACT, (const char*)Wdn, (size_t)256 * DFF * 2, (size_t)256 * DFF * 2, 1};
        pg8::EpiRes E{out, out + (size_t)NPROMPT * 1024, out, mod + 5120};
#if (MK_REPEAT_MASK >> 8) & 1
        { pg8::EpiRes E2{out, out + (size_t)NPROMPT * 1024, (float*)(ws + WS_ABX), mod + 5120}; pg8::gemm_phase<pg8::EpiRes, pg8::SchedGrid>(lds, DFF, DFF, S, E2); }
#endif
        pg8::gemm_phase<pg8::EpiRes, pg8::SchedGrid>(lds, DFF, DFF, S, E);
    }
#undef IN
#undef SEAM
}

extern "C" void kernel_launch(void* const* d_in, const int* in_sizes, int n_in, void* d_out, int out_size, void* d_ws, size_t ws_size, hipStream_t stream) {
    static int grid = 0;
    if (grid == 0) {
        int dev = 0, cus = 0, per_cu = 0;
        if (n_in != 19 || ws_size < 256 * MiB) { fprintf(stderr, "kernel_launch: unexpected n_in %d / ws_size %zu\n", n_in, ws_size); grid = -1; return; }
        (void)hipGetDevice(&dev);
        (void)hipDeviceGetAttribute(&cus, hipDeviceAttributeMultiprocessorCount, dev);
        if (hipFuncSetAttribute((const void*)mk_fwd, hipFuncAttributeMaxDynamicSharedMemorySize, LDS_BYTES) != hipSuccess) { fprintf(stderr, "kernel_launch: hipFuncSetAttribute failed\n"); grid = -1; return; }
        if (hipOccupancyMaxActiveBlocksPerMultiprocessor(&per_cu, (const void*)mk_fwd, 512, LDS_BYTES) != hipSuccess || per_cu < 1) { fprintf(stderr, "kernel_launch: occupancy query gives %d\n", per_cu); per_cu = 1; (void)hipGetLastError(); }
        grid = cus * 1;
        if (grid > 256) grid = 256;
        if (grid != 256) { fprintf(stderr, "kernel_launch: this kernel needs 256 CUs (got %d)\n", grid); grid = -1; return; }
    }
    if (grid < 0) return;
    if (hipMemsetAsync(d_ws, 0, 32768, stream) != hipSuccess) { fprintf(stderr, "kernel_launch: memset failed\n"); return; }
    Args a{};
    for (int i = 0; i < 19; ++i) a.in[i] = (const float*)d_in[i];
    a.out = (float*)d_out; a.ws = (unsigned char*)d_ws;
    for (int li = 0; li < (MK_N_LAUNCHES == 1 ? 1 : NPH); ++li) {
        a.ph_lo = (MK_N_LAUNCHES == 1) ? 0 : li; a.ph_hi = (MK_N_LAUNCHES == 1) ? NPH : li + 1;
        void* kargs[] = {&a};
        hipError_t e = hipLaunchCooperativeKernel((const void*)mk_fwd, dim3(grid), dim3(512), kargs, LDS_BYTES, stream);
        if (e != hipSuccess) { fprintf(stderr, "kernel_launch: cooperative launch failed: %s (grid %d)\n", hipGetErrorString(e), grid); break; }
    }
}
```
